# Optimizing an MI355X kernel written in HIP

```python
import math
import jax, jax.numpy as jnp
from jax import lax
import numpy as np


D_MODEL = 1024
BATCH = 8
SEQ = 2048
DEPTH = 4
DEC_BATCH = 128
DEC_SEQ = 4
PAST_LEN = 8192
PAGE_SIZE = 128

HEAD_DIM = 64
MIX_WIDTH = D_MODEL
H_A = MIX_WIDTH // 256
H_B = MIX_WIDTH // 128
KV_HEADS = 2
GQA_GROUP = H_B // KV_HEADS
H_C = MIX_WIDTH // 256
W_A = H_A * HEAD_DIM
W_B = H_B * HEAD_DIM
W_KV = KV_HEADS * HEAD_DIM
W_C = H_C * HEAD_DIM
CHUNK = 128
WINDOW = 128
CONV_W = 3
D_FF = ((8 * D_MODEL) // 3 + 255) // 256 * 256
EPS = 1e-6
NEG = -1e30
SCALE = HEAD_DIM ** -0.5
PROJ_SIZES = [W_A, W_A, W_B, W_KV, W_KV, W_C, W_C, W_C]
IN_WIDTH = sum(PROJ_SIZES)
PROJ_SPLITS = np.cumsum(PROJ_SIZES)[:-1].tolist()

kernel_name = "hymba_style_gmlp_swa_conv_macaron_step"


def rms_norm(x, g):
    xf = x.astype(jnp.float32)
    y = xf * lax.rsqrt(jnp.mean(xf * xf, axis=-1, keepdims=True) + EPS)
    return (y * g.astype(jnp.float32)).astype(x.dtype)


def head_layer_norm(v, g):
    vf = v.astype(jnp.float32)
    mu = jnp.mean(vf, axis=-1, keepdims=True)
    var = jnp.mean(jnp.square(vf - mu), axis=-1, keepdims=True)
    return ((vf - mu) * lax.rsqrt(var + EPS) * g.astype(jnp.float32)).astype(v.dtype)


def swiglu(x, w_gu, w_down):
    gate, up = jnp.split(x @ w_gu, 2, axis=-1)
    return (jax.nn.silu(gate) * up) @ w_down


def half_ffn(x, g_pre, g_post, w_gu, w_down):
    return x + 0.5 * rms_norm(swiglu(rms_norm(x, g_pre), w_gu, w_down), g_post)


def alibi_slopes():
    return jnp.asarray(2.0 ** (-8.0 * np.arange(1, H_B + 1) / H_B), dtype=jnp.float32)


def sink_softmax(scores, sink):
    sink = sink.astype(jnp.float32)
    m = jnp.maximum(jnp.max(scores, axis=-1, keepdims=True), sink)
    p = jnp.exp(scores - m)
    return p / (jnp.sum(p, axis=-1, keepdims=True) + jnp.exp(sink - m))


def chunk_mlp(ua, va, w_sgu, b_sgu, g_sgu):
    B, S, _ = ua.shape
    L = min(S, CHUNK)
    n = S // L
    u = jax.nn.gelu(ua, approximate=False).reshape(B, n, L, H_A, HEAD_DIM)
    v = head_layer_norm(jax.nn.gelu(va, approximate=False).reshape(B, S, H_A, HEAD_DIM),
                        g_sgu.reshape(H_A, HEAD_DIM))
    w = jnp.where(jnp.tril(jnp.ones((L, L), dtype=bool)), w_sgu[:, :L, :L], 0)
    mix = jnp.einsum('hts,bnshd->bnthd', w, v.reshape(B, n, L, H_A, HEAD_DIM))
    mix = mix + b_sgu[:, :L].T[None, None, :, :, None]
    return (u * mix).reshape(B, S, W_A), v


def swa_prompt(q, k, v, sinks, slopes):
    B, S = q.shape[:2]
    nb = S // WINDOW
    qb = q.reshape(B, nb, WINDOW, KV_HEADS, GQA_GROUP, HEAD_DIM)

    def band(t):
        tb = t.reshape(B, nb, WINDOW, KV_HEADS, HEAD_DIM)
        prev = jnp.pad(tb[:, :-1], ((0, 0), (1, 0), (0, 0), (0, 0), (0, 0)))
        return jnp.concatenate([prev, tb], axis=2)

    kb, vb = band(k), band(v)
    kpos = jnp.arange(2 * WINDOW)
    dist = (WINDOW + jnp.arange(WINDOW))[:, None] - kpos[None, :]
    valid = ((dist >= 0) & (dist < WINDOW))[None] & \
        ((jnp.arange(nb) > 0)[:, None, None] | (kpos >= WINDOW)[None, None, :])
    scores = jnp.einsum('bnqkgd,bnskd->bnkgqs', qb, kb,
                        preferred_element_type=jnp.float32) * SCALE
    scores = scores - slopes.reshape(KV_HEADS, GQA_GROUP)[:, :, None, None] * dist.astype(jnp.float32)
    scores = jnp.where(valid[None, :, None, None], scores, NEG)
    probs = sink_softmax(scores, sinks.reshape(KV_HEADS, GQA_GROUP)[:, :, None, None])
    out = jnp.einsum('bnkgqs,bnskd->bnqkgd', probs.astype(vb.dtype), vb)
    return out.reshape(B, S, W_B)


def swa_sample(q, k, v, k_buf, v_buf, sinks, slopes):
    Bd, T = q.shape[:2]
    k_all = jnp.concatenate([k_buf, k], axis=1)
    v_all = jnp.concatenate([v_buf, v], axis=1)
    dist = (WINDOW + jnp.arange(T))[:, None] - jnp.arange(WINDOW + T)[None, :]
    valid = (dist >= 0) & (dist < WINDOW)
    scores = jnp.einsum('btkgd,bskd->bkgts', q, k_all,
                        preferred_element_type=jnp.float32) * SCALE
    scores = scores - slopes.reshape(KV_HEADS, GQA_GROUP)[:, :, None, None] * dist.astype(jnp.float32)
    scores = jnp.where(valid[None, None, None], scores, NEG)
    probs = sink_softmax(scores, sinks.reshape(KV_HEADS, GQA_GROUP)[:, :, None, None])
    out = jnp.einsum('bkgts,bskd->btkgd', probs.astype(v_all.dtype), v_all)
    return out.reshape(Bd, T, W_B), k_all[:, T:], v_all[:, T:]


def short_conv(zp, w_conv, T):
    y = zp[:, 0:T] * w_conv[0]
    for j in range(1, CONV_W):
        y = y + zp[:, j:j + T] * w_conv[j]
    return y


def merge_groups(ya, yb, yc, g_out, w_out):
    ga, gb, gc = jnp.split(g_out, [W_A, W_A + W_B])
    y = jnp.concatenate([rms_norm(ya, ga), rms_norm(yb, gb), rms_norm(yc, gc)], axis=-1)
    return y @ w_out


def mixer_prompt(h, w_in, w_out, g_out, w_sgu, b_sgu, g_sgu, sinks, w_conv, slopes):
    B, S, _ = h.shape
    ua, va, q, k, v, gb, gc, hc = jnp.split(h @ w_in, PROJ_SPLITS, axis=-1)
    ya, _ = chunk_mlp(ua, va, w_sgu, b_sgu, g_sgu)
    k = k.reshape(B, S, KV_HEADS, HEAD_DIM)
    v = v.reshape(B, S, KV_HEADS, HEAD_DIM)
    yb = swa_prompt(q.reshape(B, S, KV_HEADS, GQA_GROUP, HEAD_DIM), k, v, sinks, slopes)
    z = gc * hc
    zp = jnp.pad(z, ((0, 0), (CONV_W - 1, 0), (0, 0)))
    yc = gb * short_conv(zp, w_conv, S)
    y = merge_groups(ya, yb, yc, g_out, w_out)
    return y, k[:, S - WINDOW:], v[:, S - WINDOW:], z[:, S - (CONV_W - 1):]


def mixer_sample(h, k_buf, v_buf, conv_buf, w_in, w_out, g_out, w_sgu, b_sgu, g_sgu, sinks, w_conv, slopes):
    Bd, T, _ = h.shape
    ua, va, q, k, v, gb, gc, hc = jnp.split(h @ w_in, PROJ_SPLITS, axis=-1)
    ya, v_sgu = chunk_mlp(ua, va, w_sgu, b_sgu, g_sgu)
    yb, k_new, v_new = swa_sample(q.reshape(Bd, T, KV_HEADS, GQA_GROUP, HEAD_DIM),
                                  k.reshape(Bd, T, KV_HEADS, HEAD_DIM),
                                  v.reshape(Bd, T, KV_HEADS, HEAD_DIM),
                                  k_buf, v_buf, sinks, slopes)
    z = gc * hc
    zp = jnp.concatenate([conv_buf, z], axis=1)
    yc = gb * short_conv(zp, w_conv, T)
    y = merge_groups(ya, yb, yc, g_out, w_out)
    return y, v_sgu, k_new, v_new, zp[:, T:]


def setup_inputs(seed: int = 0) -> dict:
    key = jax.random.key(seed)
    ks = jax.random.split(key, 16)
    f32 = jnp.float32

    def nrm(k, shape, s):
        return jax.random.normal(k, shape, f32) * s

    return {
        "x_prompt": nrm(ks[0], (BATCH, SEQ, D_MODEL), 1.0),
        "x_sample": nrm(ks[1], (DEC_BATCH, DEC_SEQ, D_MODEL), 1.0),
        "cache_swa_k": nrm(ks[2], (DEPTH, DEC_BATCH, WINDOW, KV_HEADS, HEAD_DIM), 1.0),
        "cache_swa_v": nrm(ks[3], (DEPTH, DEC_BATCH, WINDOW, KV_HEADS, HEAD_DIM), 1.0),
        "cache_conv": nrm(ks[4], (DEPTH, DEC_BATCH, CONV_W - 1, W_C), 1.0),
        "norm_g": 1.0 + nrm(ks[5], (DEPTH, 6, D_MODEL), 0.05),
        "w_ffn_gu": nrm(ks[6], (DEPTH, 2, D_MODEL, 2 * D_FF), D_MODEL ** -0.5),
        "w_ffn_down": nrm(ks[7], (DEPTH, 2, D_FF, D_MODEL), D_FF ** -0.5),
        "w_mix_in": nrm(ks[8], (DEPTH, D_MODEL, IN_WIDTH), D_MODEL ** -0.5),
        "w_mix_out": nrm(ks[9], (DEPTH, MIX_WIDTH, D_MODEL), MIX_WIDTH ** -0.5),
        "g_mix_out": 1.0 + nrm(ks[10], (DEPTH, MIX_WIDTH), 0.05),
        "w_sgu": nrm(ks[11], (DEPTH, H_A, CHUNK, CHUNK), CHUNK ** -0.5),
        "b_sgu": 1.0 + nrm(ks[12], (DEPTH, H_A, CHUNK), 0.1),
        "g_sgu": 1.0 + nrm(ks[13], (DEPTH, W_A), 0.05),
        "attn_sinks": nrm(ks[14], (DEPTH, H_B), 1.0),
        "w_conv": nrm(ks[15], (DEPTH, CONV_W, W_C), CONV_W ** -0.5),
    }


def reference(x_prompt, x_sample, cache_swa_k, cache_swa_v, cache_conv, norm_g, w_ffn_gu, w_ffn_down,
              w_mix_in, w_mix_out, g_mix_out, w_sgu, b_sgu, g_sgu, attn_sinks, w_conv):
    slopes = alibi_slopes()
    xp, xs = x_prompt, x_sample
    sgu_s, kp_l, vp_l, ks_l, vs_l, cp_l, cs_l = [], [], [], [], [], [], []
    for l in range(DEPTH):
        g = norm_g[l]
        xp = half_ffn(xp, g[0], g[1], w_ffn_gu[l, 0], w_ffn_down[l, 0])
        xs = half_ffn(xs, g[0], g[1], w_ffn_gu[l, 0], w_ffn_down[l, 0])
        mp, kp, vp, cp = mixer_prompt(rms_norm(xp, g[2]), w_mix_in[l], w_mix_out[l], g_mix_out[l],
                                      w_sgu[l], b_sgu[l], g_sgu[l], attn_sinks[l], w_conv[l], slopes)
        xp = xp + rms_norm(mp, g[3])
        ms, vsg, kn, vn, cn = mixer_sample(rms_norm(xs, g[2]), cache_swa_k[l], cache_swa_v[l], cache_conv[l],
                                           w_mix_in[l], w_mix_out[l], g_mix_out[l], w_sgu[l], b_sgu[l],
                                           g_sgu[l], attn_sinks[l], w_conv[l], slopes)
        xs = xs + rms_norm(ms, g[3])
        xp = half_ffn(xp, g[4], g[5], w_ffn_gu[l, 1], w_ffn_down[l, 1])
        xs = half_ffn(xs, g[4], g[5], w_ffn_gu[l, 1], w_ffn_down[l, 1])
        sgu_s.append(vsg)
        kp_l.append(kp)
        vp_l.append(vp)
        ks_l.append(kn)
        vs_l.append(vn)
        cp_l.append(cp)
        cs_l.append(cn)
    return (xp, xs, jnp.stack(sgu_s), jnp.stack(kp_l), jnp.stack(vp_l), jnp.stack(ks_l),
            jnp.stack(vs_l), jnp.stack(cp_l), jnp.stack(cs_l))
```

```cpp
#include <hip/hip_runtime.h>
#include <hip/hip_cooperative_groups.h>
#include <cstdio>
namespace cg = cooperative_groups;

#define LAS __attribute__((address_space(3)))
typedef unsigned short bf16_t;
typedef short bf16x8 __attribute__((ext_vector_type(8)));
typedef short s16x4 __attribute__((ext_vector_type(4)));
typedef float f32x2 __attribute__((ext_vector_type(2)));
typedef float f32x4 __attribute__((ext_vector_type(4)));
typedef float f32x16 __attribute__((ext_vector_type(16)));
typedef unsigned u32x2 __attribute__((ext_vector_type(2)));
typedef unsigned u32x4 __attribute__((ext_vector_type(4)));
typedef __bf16 bf16v2 __attribute__((ext_vector_type(2)));

constexpr int TP = 16384, TS = 512, T = TP + TS, DM = 1024, FF = 2816, NGU = 2 * FF, NIN = 2048, PW = 1792, DEPTH = 4;
constexpr float EPS = 1e-6f;
constexpr float NEGF = -1e30f;
constexpr float LOG2E = 1.4426950408889634f;
constexpr int PC_U = 0, PC_V = 256, PC_Q = 512, PC_K = 1024, PC_VV = 1152, PC_GB = 1280, PC_Z = 1536;
constexpr size_t O_SGUV = 17301504, O_KP = 17825792, O_VP = 18350080, O_KS = 18874368, O_VS = 27262976, O_CP = 35651584, O_CS = 35667968;
constexpr size_t WS_XB = 0;
constexpr size_t WS_RS = WS_XB + (size_t)T * DM * 2;
constexpr size_t WS_ACT = WS_RS + (size_t)T * 16;
constexpr size_t WS_DM = WS_ACT + (size_t)T * FF * 2;
constexpr size_t WS_P = WS_DM + (size_t)T * DM * 4;
constexpr size_t WS_Y = WS_P + (size_t)T * PW * 2;
constexpr size_t WS_WGU = WS_Y + (size_t)T * DM * 2;
constexpr size_t WS_WDN = WS_WGU + (size_t)8 * NGU * DM * 2;
constexpr size_t WS_WIN = WS_WDN + (size_t)8 * DM * FF * 2;
constexpr size_t WS_WOUT = WS_WIN + (size_t)4 * NIN * DM * 2;
constexpr size_t WS_WSGU = WS_WOUT + (size_t)4 * DM * DM * 2;
constexpr size_t WS_PS1 = WS_WSGU + (size_t)4 * 4 * 128 * 128 * 2;
constexpr size_t WS_BAR = WS_PS1 + (size_t)TP * 16;
constexpr int CTL_BYTES = 32768;
constexpr size_t WS_END = WS_BAR + CTL_BYTES;
#define CW_CNT(pm) (3584 + 64 * (pm))
#define CW_CNTS (3584 + 64 * 64)
constexpr int LDS_BYTES = 144 * 1024;
#ifndef REP_GEMM
#define REP_GEMM 1
#endif
#ifndef REP_MIX
#define REP_MIX 1
#endif
#ifndef REP_PRO
#define REP_PRO 1
#endif
#ifndef REP_ATT
#define REP_ATT 1
#endif
#ifndef REP_SGU
#define REP_SGU 1
#endif
#ifndef REP_SMP
#define REP_SMP 1
#endif

struct Args {
    const float *x_prompt, *x_sample, *cache_k, *cache_v, *cache_conv, *norm_g, *w_gu, *w_down, *w_in, *w_out, *g_out, *w_sgu, *b_sgu, *g_sgu, *sinks, *w_conv;
    float* out; unsigned char* ws;
};

__device__ __forceinline__ float bf2f(bf16_t b) { return __uint_as_float(((unsigned)b) << 16); }
__device__ __forceinline__ float bflo(unsigned w) { return __uint_as_float(w << 16); }
__device__ __forceinline__ float bfhi(unsigned w) { return __uint_as_float(w & 0xffff0000u); }
__device__ __forceinline__ unsigned pk2(float a, float b) { f32x2 v = {a, b}; bf16v2 r = __builtin_convertvector(v, bf16v2); return __builtin_bit_cast(unsigned, r); }
__device__ __forceinline__ bf16_t f2bf(float a) { return (bf16_t)(pk2(a, 0.f) & 0xffffu); }
__device__ __forceinline__ float wave_sum(float v) {
#pragma unroll
    for (int o = 1; o < 64; o <<= 1) v += __shfl_xor(v, o);
    return v;
}
__device__ __forceinline__ float wave_max(float v) {
#pragma unroll
    for (int o = 1; o < 64; o <<= 1) v = fmaxf(v, __shfl_xor(v, o));
    return v;
}
__device__ __forceinline__ float fast_exp(float x) { return __builtin_amdgcn_exp2f(x * LOG2E); }
__device__ __forceinline__ float fast_rsqrt(float x) { return __builtin_amdgcn_rsqf(x); }
__device__ __forceinline__ float rs_of(const float* ps, int row) { const f32x4 p = *(const f32x4*)(ps + (size_t)row * 4); return fast_rsqrt(((p[0] + p[1]) + (p[2] + p[3])) * (1.f / DM) + EPS); }
#define LDS_WAIT() asm volatile("s_waitcnt lgkmcnt(0)" ::: "memory")
__device__ __forceinline__ int opaque_tid() { int t = threadIdx.x; asm volatile("" : "+v"(t)); return t; }
#define MFMA32(a, b, c) __builtin_amdgcn_mfma_f32_32x32x16_bf16((a), (b), (c), 0, 0, 0)

__device__ __forceinline__ f32x2 gelu_pk(f32x2 v) {
    const f32x2 av = __builtin_elementwise_abs(v), d = av * 0.2316418882f + 1.0f;
    f32x2 t; t.x = __builtin_amdgcn_rcpf(d.x); t.y = __builtin_amdgcn_rcpf(d.y);
    f32x2 q = t * 0.5307027145f + (-0.7265760135f); q = q * t + 0.7107068705f; q = q * t + (-0.142248368f); q = q * t + 0.127414796f; q = q * t;
    const f32x2 s = (v * v) * (-0.72134752044f);
    f32x2 e; e.x = __builtin_amdgcn_exp2f(s.x); e.y = __builtin_amdgcn_exp2f(s.y);
    const f32x2 m = v * (q * e), r = v - m;
    f32x2 o; o.x = v.x < 0.f ? m.x : r.x; o.y = v.y < 0.f ? m.y : r.y; return o;
}
__device__ __forceinline__ f32x4 gelu4(f32x4 v) { f32x2 a = gelu_pk((f32x2){v[0], v[1]}), b = gelu_pk((f32x2){v[2], v[3]}); return (f32x4){a.x, a.y, b.x, b.y}; }
__device__ __forceinline__ float silu1(float x) { return x * __builtin_amdgcn_rcpf(1.0f + __builtin_amdgcn_exp2f(-x * LOG2E)); }


#define XB_TMO      128
#define XB_XCNT(j)  (256  + 64 * (j))
#define XB_XSUB(j)  (1280 + 64 * (j))
#define XB_XGEN(j)  (2304 + 64 * (j))
#define XB_TOP      3328
#define XB_TOPGEN   3392
#define XCD_BAR_WORDS 3456
#define XB_SPIN_CAP (1u << 22)
__device__ __forceinline__ unsigned xb_ld(unsigned* p)              { return __hip_atomic_load(p, __ATOMIC_RELAXED, __HIP_MEMORY_SCOPE_AGENT); }
__device__ __forceinline__ unsigned xb_add(unsigned* p, unsigned v) { return __hip_atomic_fetch_add(p, v, __ATOMIC_RELAXED, __HIP_MEMORY_SCOPE_AGENT); }
__device__ __forceinline__ unsigned xb_xcc_id() { return (unsigned)__builtin_amdgcn_s_getreg((3 << 11) | 20) & 0xFu; }
#define XB_SPIN(cond, bar) do { unsigned _sp = 0; while (cond) { __builtin_amdgcn_s_sleep(1); \
    if ((++_sp & 255u) == 0u) { if (xb_ld(&(bar)[XB_TMO])) break; if (_sp > XB_SPIN_CAP) { atomicAdd(&(bar)[XB_TMO], 1u); break; } } } } while (0)
__device__ __forceinline__ void xcd_barrier_complete(unsigned* bar, unsigned x, unsigned& nloc, unsigned& nx) {
    const unsigned G = gridDim.x * gridDim.y * gridDim.z;
    unsigned sum, cnt, mine, sp = 0u;
    for (;;) {
        sum = 0u; cnt = 0u; mine = 0u;
#pragma unroll
        for (unsigned j = 0; j < 16; ++j) { const unsigned c = xb_ld(&bar[XB_XCNT(j)]); sum += c; cnt += (c > 0u) ? 1u : 0u; mine = (j == x) ? c : mine; }
        if (sum == G) break;
        __builtin_amdgcn_s_sleep(1);
        if ((++sp & 255u) == 0u) { if (xb_ld(&bar[XB_TMO])) break; if (sp > XB_SPIN_CAP) { atomicAdd(&bar[XB_TMO], 1u); break; } }
    }
    nloc = mine > 0u ? mine : 1u; nx = cnt > 0u ? cnt : 1u;
}
__device__ __forceinline__ void xcd_barrier(unsigned* bar, volatile LAS unsigned* st) {
    asm volatile("s_waitcnt vmcnt(0)" ::: "memory");
    __syncthreads();
    if (threadIdx.x == 0) {
        const unsigned x = xb_xcc_id();
        __builtin_amdgcn_s_waitcnt(0);
        unsigned nloc = st[0], nx = st[1];
        if (nloc == 0u) { xcd_barrier_complete(bar, x, nloc, nx); st[0] = nloc; st[1] = nx; }
        const unsigned old = xb_add(&bar[XB_XSUB(x)], 1u);
        const unsigned gen = old / nloc;
        if (old + 1u == (gen + 1u) * nloc) {
            __builtin_amdgcn_fence(__ATOMIC_RELEASE, "agent");
            asm volatile("s_waitcnt vmcnt(0)" ::: "memory");
            const unsigned og = xb_add(&bar[XB_TOP], 1u);
            const unsigned tg = og / nx;
            if (og + 1u == (tg + 1u) * nx) xb_add(&bar[XB_TOPGEN], 1u);
            else XB_SPIN(xb_ld(&bar[XB_TOPGEN]) == tg, bar);
            __builtin_amdgcn_fence(__ATOMIC_ACQUIRE, "agent");
            xb_add(&bar[XB_XGEN(x)], 1u);
            asm volatile("s_waitcnt vmcnt(0)" ::: "memory");
        } else {
            XB_SPIN(xb_ld(&bar[XB_XGEN(x)]) == gen, bar);
            __builtin_amdgcn_fence(__ATOMIC_ACQUIRE, "agent");
            asm volatile("s_waitcnt vmcnt(0)" ::: "memory");
        }
    }
    __syncthreads();
}

namespace pg8 {
constexpr int BM = 256, BK = 64, HALF = 128, HTB = HALF * BK * 2, STAGE_BYTES = 8 * HTB, NXCD = 8, WGM = 8;
__host__ __device__ __forceinline__ int lds_byte(int r, int c) { const int st = (r >> 4) * 2 + (c >> 5), rr = r & 15, cc = c & 31, ob = rr * 64 + cc * 2; return st * 1024 + (ob ^ (((ob >> 9) & 1) << 5)); }
__host__ __device__ __forceinline__ void stage_rc(int b, int& R, int& C) { const int st = b / 1024, sb = b % 1024, swz = sb ^ (((sb >> 9) & 1) << 5); R = (st >> 1) * 16 + swz / 64; C = (st & 1) * 32 + (swz % 64) / 2; }
__host__ __device__ __forceinline__ int perm32(int rho) { const int n = rho >> 4, i = rho & 15; return 8 * (i >> 2) + 4 * n + (i & 3); }
struct Unit { int pm, pn; };
struct Gemm { const bf16_t* A; const bf16_t* Bt; int M, N, K; };
struct StaticOrder {
    int nM, nN, nwg, G, c;
    __device__ void init(int M, int N, int G_, int c_) { nM = M / BM; nN = N / BM; nwg = nM * nN; G = G_; c = c_; }
    __device__ bool next(int i, Unit& u) const {
        const long L = (long)i * G + c; if (L >= nwg) return false;
        int wgid = (int)L; { const int q = nwg / NXCD, r = nwg % NXCD, xcd = wgid % NXCD, off = wgid / NXCD; wgid = (xcd < r ? xcd * (q + 1) : r * (q + 1) + (xcd - r) * q) + off; }
        const int nig = WGM * nN, gid = wgid / nig, fm = gid * WGM, gsz = (nM - fm) < WGM ? (nM - fm) : WGM;
        u.pm = fm + ((wgid % nig) % gsz); u.pn = (wgid % nig) / gsz; return true;
    }
};

struct EpiF32 {
    static constexpr bool PERM = false, AFTER_DRAIN = false;
    float* C; int ldc;
    __device__ __forceinline__ void operator()(const f32x4 (&acc)[2][2][4][2], const Unit& u, int wr, int wc, int fr, int fq) const {
        const int row0 = u.pm * BM + wr * 64 + fr, col0 = u.pn * BM + wc * 32 + 4 * fq;
#pragma unroll
        for (int ai = 0; ai < 2; ++ai)
#pragma unroll
            for (int m = 0; m < 4; ++m) { float* rowp = C + (size_t)(row0 + ai * HALF + m * 16) * ldc + col0;
#pragma unroll
                for (int bj = 0; bj < 2; ++bj)
#pragma unroll
                    for (int n = 0; n < 2; ++n) *(f32x4*)(rowp + bj * HALF + n * 16) = acc[ai][bj][m][n]; }
    }
};
struct EpiSwiglu {
    static constexpr bool PERM = true, AFTER_DRAIN = false;
    bf16_t* O; const float* rs;
    __device__ __forceinline__ void operator()(const f32x4 (&acc)[2][2][4][2], const Unit& u, int wr, int wc, int fr, int fq) const {
        const int row0 = u.pm * BM + wr * 64 + fr, col0 = u.pn * HALF + wc * 32 + 8 * fq;
#pragma unroll
        for (int ai = 0; ai < 2; ++ai)
#pragma unroll
            for (int m = 0; m < 4; ++m) { const int row = row0 + ai * HALF + m * 16; const float s = rs_of(rs, row);
                const float c1 = -s * LOG2E, s2 = s * s; u32x4 w;
#pragma unroll
                for (int n = 0; n < 2; ++n)
#pragma unroll
                    for (int jp = 0; jp < 2; ++jp) { const f32x2 g = {acc[ai][0][m][n][2 * jp], acc[ai][0][m][n][2 * jp + 1]}, up = {acc[ai][1][m][n][2 * jp], acc[ai][1][m][n][2 * jp + 1]};
                        const f32x2 t = g * c1; f32x2 e; e.x = __builtin_amdgcn_exp2f(t.x); e.y = __builtin_amdgcn_exp2f(t.y);
                        const f32x2 d = e + 1.0f; f32x2 r; r.x = __builtin_amdgcn_rcpf(d.x); r.y = __builtin_amdgcn_rcpf(d.y);
                        const f32x2 o = (g * up) * (r * s2);
                        w[2 * n + jp] = pk2(o.x, o.y); }
                *(u32x4*)(O + (size_t)row * FF + col0) = w; }
    }
};
struct EpiMixIn {
    static constexpr bool PERM = true, AFTER_DRAIN = false;
    bf16_t* P; const float* rs;
    __device__ __forceinline__ void operator()(const f32x4 (&acc)[2][2][4][2], const Unit& u, int wr, int wc, int fr, int fq) const {
        const int row0 = u.pm * BM + wr * 64 + fr, pn = u.pn;
        if (pn >= 6) {
            const int col0 = PC_Z + HALF * (pn - 6) + wc * 32 + 8 * fq;
#pragma unroll
            for (int ai = 0; ai < 2; ++ai)
#pragma unroll
                for (int m = 0; m < 4; ++m) { const int row = row0 + ai * HALF + m * 16; const float s = rs_of(rs, row), s2 = s * s;
                    const f32x4 v0 = acc[ai][0][m][0] * acc[ai][1][m][0] * s2, v1 = acc[ai][0][m][1] * acc[ai][1][m][1] * s2;
                    u32x4 w; w.x = pk2(v0[0], v0[1]); w.y = pk2(v0[2], v0[3]); w.z = pk2(v1[0], v1[1]); w.w = pk2(v1[2], v1[3]);
                    *(u32x4*)(P + (size_t)row * PW + col0) = w; }
        } else {
            const int col0 = BM * pn + wc * 32 + 8 * fq;
#pragma unroll
            for (int ai = 0; ai < 2; ++ai)
#pragma unroll
                for (int m = 0; m < 4; ++m) { const int row = row0 + ai * HALF + m * 16; const float s = rs_of(rs, row);
#pragma unroll
                    for (int bj = 0; bj < 2; ++bj) { f32x4 v0 = acc[ai][bj][m][0] * s, v1 = acc[ai][bj][m][1] * s;
                        if (pn < 2) { v0 = gelu4(v0); v1 = gelu4(v1); }
                        u32x4 w; w.x = pk2(v0[0], v0[1]); w.y = pk2(v0[2], v0[3]); w.z = pk2(v1[0], v1[1]); w.w = pk2(v1[2], v1[3]);
                        *(u32x4*)(P + (size_t)row * PW + col0 + bj * HALF) = w; } }
        }
    }
};


struct EpiResNorm {
    static constexpr bool PERM = true, AFTER_DRAIN = true;
    float* Xf; bf16_t* XB; float* PS1; float* PS2; unsigned* cnt; const float* g; float coef; unsigned target;
    __device__ __forceinline__ void fused(const f32x4 (&acc)[2][2][4][2], const Unit& u, int wr, int wc, int fr, int fq, LAS unsigned char* lds, int wid, int lane) const {
        LAS float* tab = (LAS float*)lds;
        LAS float* scl = tab + 1024;
        const int tid = wid * 64 + lane;
#pragma unroll
        for (int ai = 0; ai < 2; ++ai)
#pragma unroll
            for (int m = 0; m < 4; ++m) { float p = 0.f;
#pragma unroll
                for (int bj = 0; bj < 2; ++bj)
#pragma unroll
                    for (int n = 0; n < 2; ++n) { const f32x4 v = acc[ai][bj][m][n]; p += (v[0] * v[0] + v[1] * v[1]) + (v[2] * v[2] + v[3] * v[3]); }
                p += __shfl_xor(p, 16); p += __shfl_xor(p, 32);
                if (fq == 0) tab[(ai * HALF + wr * 64 + m * 16 + fr) * 4 + wc] = p; }
        __syncthreads();
        if (tid < 256) { const f32x4 t4 = *(const LAS f32x4*)(tab + tid * 4);
            __hip_atomic_store(PS1 + (size_t)u.pn * TP + (u.pm * BM + tid), (t4[0] + t4[1]) + (t4[2] + t4[3]), __ATOMIC_RELAXED, __HIP_MEMORY_SCOPE_AGENT); }
        asm volatile("s_waitcnt vmcnt(0)" ::: "memory");
        __syncthreads();
        if (tid == 0) { unsigned* c = cnt + CW_CNT(u.pm);
            __hip_atomic_fetch_add(c, 1u, __ATOMIC_RELAXED, __HIP_MEMORY_SCOPE_AGENT);
            unsigned sp = 0; while (__hip_atomic_load(c, __ATOMIC_RELAXED, __HIP_MEMORY_SCOPE_AGENT) < target) { __builtin_amdgcn_s_sleep(1); if (++sp > (1u << 24)) break; }
            asm volatile("s_waitcnt vmcnt(0)" ::: "memory"); }
        __syncthreads();
        if (tid < 256) { const float* p = PS1 + (u.pm * BM + tid); float t = 0.f;
#pragma unroll
            for (int k = 0; k < 4; ++k) t += __hip_atomic_load(p + (size_t)k * TP, __ATOMIC_RELAXED, __HIP_MEMORY_SCOPE_AGENT);
            scl[tid] = fast_rsqrt(t * (1.f / DM) + EPS) * coef; }
        __syncthreads();
        const int col0 = u.pn * BM + wc * 32 + 8 * fq;
        f32x4 gv[2][2];
#pragma unroll
        for (int bj = 0; bj < 2; ++bj)
#pragma unroll
            for (int n = 0; n < 2; ++n) gv[bj][n] = *(const f32x4*)(g + col0 + bj * HALF + 4 * n);
        u32x4 xw[2][4][2];
#pragma unroll
        for (int ai = 0; ai < 2; ++ai)
#pragma unroll
            for (int m = 0; m < 4; ++m)
#pragma unroll
                for (int bj = 0; bj < 2; ++bj) xw[ai][m][bj] = *(const u32x4*)(XB + ((size_t)u.pm * BM + ai * HALF + wr * 64 + m * 16 + fr) * DM + col0 + bj * HALF);
#pragma unroll
        for (int ai = 0; ai < 2; ++ai)
#pragma unroll
            for (int m = 0; m < 4; ++m) { const int lrow = ai * HALF + wr * 64 + m * 16 + fr; const size_t row = (size_t)u.pm * BM + lrow; const float sc = scl[lrow]; float p2 = 0.f;
#pragma unroll
                for (int bj = 0; bj < 2; ++bj) { const u32x4 w = xw[ai][m][bj];
                    f32x4 x0 = {bflo(w.x), bfhi(w.x), bflo(w.y), bfhi(w.y)}, x1 = {bflo(w.z), bfhi(w.z), bflo(w.w), bfhi(w.w)};
                    x0 = x0 + acc[ai][bj][m][0] * gv[bj][0] * sc; x1 = x1 + acc[ai][bj][m][1] * gv[bj][1] * sc;
                    p2 += ((x0[0] * x0[0] + x0[1] * x0[1]) + (x0[2] * x0[2] + x0[3] * x0[3])) + ((x1[0] * x1[0] + x1[1] * x1[1]) + (x1[2] * x1[2] + x1[3] * x1[3]));
                    u32x4 o; o.x = pk2(x0[0], x0[1]); o.y = pk2(x0[2], x0[3]); o.z = pk2(x1[0], x1[1]); o.w = pk2(x1[2], x1[3]);
                    *(u32x4*)(XB + row * DM + col0 + bj * HALF) = o;
                    if (Xf) { *(f32x4*)(Xf + row * DM + col0 + bj * HALF) = x0; *(f32x4*)(Xf + row * DM + col0 + bj * HALF + 4) = x1; } }
                p2 += __shfl_xor(p2, 16); p2 += __shfl_xor(p2, 32);
                if (fq == 0) tab[lrow * 4 + wc] = p2; }
        __syncthreads();
        if (tid < 256) { const f32x4 t4 = *(const LAS f32x4*)(tab + tid * 4); PS2[(size_t)(u.pm * BM + tid) * 4 + u.pn] = (t4[0] + t4[1]) + (t4[2] + t4[3]); }
        __syncthreads();
    }
};

template <class Epi, bool ALIGN_EPI = false, bool SP2 = false>
__device__ __forceinline__ void gemm_phase(LAS unsigned char* lds, const Gemm g, const StaticOrder& S, const Epi& E) {
    const int tid = opaque_tid(), wid = __builtin_amdgcn_readfirstlane(tid >> 6), lane = tid & 63, wr = wid >> 2, wc = wid & 3, fr = lane & 15, fq = lane >> 4;
    const int K = g.K, nt = K / BK;
    unsigned voffA[2], voffB[2];
#pragma unroll
    for (int i = 0; i < 2; ++i) { int R, C; stage_rc(tid * 16 + i * 8192, R, C); const int Rb = Epi::PERM ? ((R & ~31) + perm32(R & 31)) : R;
        voffA[i] = (unsigned)(R * K + C) * 2u; voffB[i] = (unsigned)(Rb * K + C) * 2u; }
    const size_t kstep = (size_t)(BK * 2);
    const size_t hstep = (size_t)HALF * K * 2;
    const size_t tstep = 2 * hstep;
    const unsigned ldsw = (unsigned)wid * 1024u;
    const int aoff = lds_byte(wr * 64 + fr, fq * 8), boff = lds_byte(wc * 32 + fr, fq * 8);
#define PG8_SA(b, h) (((b) * 2 + (h)) * HTB)
#define PG8_SB(b, h) ((4 + (b) * 2 + (h)) * HTB)
#define PG8_STAGE(bufoff, gbase, voff) do { _Pragma("unroll") for (int _i = 0; _i < 2; ++_i) \
        __builtin_amdgcn_global_load_lds((const unsigned*)((const char*)(gbase) + (voff)[_i]), (LAS unsigned*)(lds + (bufoff) + ldsw + _i * 8192), 16, 0, 0); } while (0)
#define PG8_LDA(dst, b, h) do { _Pragma("unroll") for (int m = 0; m < 4; ++m) _Pragma("unroll") for (int k = 0; k < 2; ++k) dst[m][k] = *(const LAS bf16x8*)(lds + PG8_SA(b, h) + aoff + m * 2048 + k * 1024); } while (0)
#define PG8_LDB(dst, b, h) do { _Pragma("unroll") for (int n = 0; n < 2; ++n) _Pragma("unroll") for (int k = 0; k < 2; ++k) dst[n][k] = *(const LAS bf16x8*)(lds + PG8_SB(b, h) + boff + n * 2048 + k * 1024); } while (0)
#define PG8_MMA(ai, bj, At, Bt) do { __builtin_amdgcn_s_setprio(1); _Pragma("unroll") for (int m = 0; m < 4; ++m) _Pragma("unroll") for (int n = 0; n < 2; ++n) _Pragma("unroll") for (int k = 0; k < 2; ++k) \
        acc[ai][bj][m][n] = __builtin_amdgcn_mfma_f32_16x16x32_bf16(Bt[n][k], At[m][k], acc[ai][bj][m][n], 0, 0, 0); __builtin_amdgcn_s_setprio(0); } while (0)
#define PG8_WAIT_V(n) asm volatile("s_waitcnt vmcnt(" #n ")" ::: "memory")
#define PG8_WAIT_L(n) asm volatile("s_waitcnt lgkmcnt(" #n ")" ::: "memory")
#define PG8_BAR __builtin_amdgcn_s_barrier()
#define PG8_SCHED __builtin_amdgcn_sched_barrier(0)
    Unit cur, nxt; int ui = 0;
    if (!S.next(0, cur)) return;
    f32x4 acc[2][2][4][2];
#pragma unroll
    for (int a = 0; a < 2; ++a)
#pragma unroll
        for (int b = 0; b < 2; ++b)
#pragma unroll
            for (int m = 0; m < 4; ++m)
#pragma unroll
                for (int n = 0; n < 2; ++n) acc[a][b][m][n] = (f32x4){0.f, 0.f, 0.f, 0.f};
    bf16x8 At[4][2], B0[2][2], B1[2][2];
    const char* cA = (const char*)g.A + (size_t)cur.pm * tstep; const char* cB = (const char*)g.Bt + (size_t)cur.pn * tstep;
    if constexpr (SP2) {
        PG8_STAGE(PG8_SB(0, 0), cB, voffB); PG8_STAGE(PG8_SB(0, 1), cB + hstep, voffB); PG8_STAGE(PG8_SA(0, 0), cA, voffA); PG8_STAGE(PG8_SA(0, 1), cA + hstep, voffA);
        if (wr == 1) PG8_BAR;
        PG8_WAIT_V(2); PG8_BAR;
        PG8_STAGE(PG8_SB(1, 0), cB + kstep, voffB); PG8_STAGE(PG8_SA(1, 0), cA + kstep, voffA); PG8_STAGE(PG8_SB(1, 1), cB + hstep + kstep, voffB);
        PG8_WAIT_V(6); PG8_BAR;
    } else {
        PG8_STAGE(PG8_SB(0, 0), cB, voffB); PG8_STAGE(PG8_SA(0, 0), cA, voffA); PG8_STAGE(PG8_SB(0, 1), cB + hstep, voffB); PG8_STAGE(PG8_SA(0, 1), cA + hstep, voffA);
        if (wr == 1) PG8_BAR;
        PG8_WAIT_V(4); PG8_BAR;
        PG8_STAGE(PG8_SB(1, 0), cB + kstep, voffB); PG8_STAGE(PG8_SA(1, 0), cA + kstep, voffA); PG8_STAGE(PG8_SB(1, 1), cB + hstep + kstep, voffB);
        PG8_WAIT_V(6); PG8_BAR;
    }
    for (;;) {
        const bool has_next = S.next(ui + 1, nxt);
        const char* nA = has_next ? (const char*)g.A + (size_t)nxt.pm * tstep : cA; const char* nB = has_next ? (const char*)g.Bt + (size_t)nxt.pn * tstep : cB;
        for (int t = 0; t < nt; t += 2) {
            const bool last = (t == nt - 2);
            const char* a1 = cA + (size_t)(t + 1) * kstep;
            const char* a2 = last ? nA : cA + (size_t)(t + 2) * kstep; const char* b2 = last ? nB : cB + (size_t)(t + 2) * kstep;
            const char* a3 = a2 + kstep; const char* b3 = b2 + kstep;
            if constexpr (SP2) {
            PG8_LDB(B0, 0, 0); PG8_LDB(B1, 0, 1); PG8_SCHED; PG8_LDA(At, 0, 0); PG8_STAGE(PG8_SA(1, 1), a1 + hstep, voffA);
            PG8_WAIT_V(8); PG8_WAIT_L(0); PG8_BAR; PG8_MMA(0, 0, At, B0); PG8_MMA(0, 1, At, B1); PG8_BAR; PG8_SCHED;
            PG8_LDA(At, 0, 1); PG8_STAGE(PG8_SB(0, 0), b2, voffB); PG8_STAGE(PG8_SB(0, 1), b2 + hstep, voffB); PG8_STAGE(PG8_SA(0, 0), a2, voffA);
            PG8_WAIT_V(8); PG8_WAIT_L(0); PG8_BAR; PG8_MMA(1, 0, At, B0); PG8_MMA(1, 1, At, B1); PG8_BAR; PG8_SCHED;
            PG8_LDB(B0, 1, 0); PG8_LDB(B1, 1, 1); PG8_SCHED; PG8_LDA(At, 1, 0); PG8_STAGE(PG8_SA(0, 1), a2 + hstep, voffA);
            PG8_WAIT_V(8); PG8_WAIT_L(0); PG8_BAR; PG8_MMA(0, 0, At, B0); PG8_MMA(0, 1, At, B1); PG8_BAR; PG8_SCHED;
            PG8_LDA(At, 1, 1); PG8_STAGE(PG8_SB(1, 0), b3, voffB); PG8_STAGE(PG8_SB(1, 1), b3 + hstep, voffB); PG8_STAGE(PG8_SA(1, 0), a3, voffA);
            PG8_WAIT_V(8); PG8_WAIT_L(0); PG8_BAR; PG8_MMA(1, 0, At, B0); PG8_MMA(1, 1, At, B1); PG8_BAR; PG8_SCHED;
            } else {
            PG8_LDB(B0, 0, 0); PG8_SCHED; PG8_LDA(At, 0, 0); PG8_STAGE(PG8_SA(1, 1), a1 + hstep, voffA);
            PG8_WAIT_L(8); PG8_BAR; PG8_WAIT_L(0); PG8_MMA(0, 0, At, B0); PG8_BAR; PG8_SCHED;
            PG8_LDB(B1, 0, 1); PG8_STAGE(PG8_SB(0, 0), b2, voffB);
            PG8_BAR; PG8_WAIT_L(0); PG8_MMA(0, 1, At, B1); PG8_BAR;
            PG8_LDA(At, 0, 1); PG8_STAGE(PG8_SA(0, 0), a2, voffA);
            PG8_BAR; PG8_WAIT_L(0); PG8_MMA(1, 0, At, B0); PG8_BAR; PG8_SCHED;
            PG8_STAGE(PG8_SB(0, 1), b2 + hstep, voffB);
            PG8_WAIT_V(6); PG8_BAR; PG8_MMA(1, 1, At, B1); PG8_BAR;
            PG8_LDB(B0, 1, 0); PG8_SCHED; PG8_LDA(At, 1, 0); PG8_STAGE(PG8_SA(0, 1), a2 + hstep, voffA);
            PG8_WAIT_L(8); PG8_BAR; PG8_WAIT_L(0); PG8_MMA(0, 0, At, B0); PG8_BAR; PG8_SCHED;
            PG8_LDB(B1, 1, 1); PG8_STAGE(PG8_SB(1, 0), b3, voffB);
            PG8_BAR; PG8_WAIT_L(0); PG8_MMA(0, 1, At, B1); PG8_BAR;
            PG8_LDA(At, 1, 1); PG8_STAGE(PG8_SA(1, 0), a3, voffA);
            PG8_BAR; PG8_WAIT_L(0); PG8_MMA(1, 0, At, B0); PG8_BAR; PG8_SCHED;
            PG8_STAGE(PG8_SB(1, 1), b3 + hstep, voffB);
            PG8_WAIT_V(6); PG8_BAR; PG8_MMA(1, 1, At, B1); PG8_BAR;
            }
        }
        if constexpr (ALIGN_EPI) { if (wr == 0) PG8_BAR; }
        if constexpr (!Epi::AFTER_DRAIN) { E(acc, cur, wr, wc, fr, fq); }
        if (!has_next) break;
#pragma unroll
        for (int a = 0; a < 2; ++a)
#pragma unroll
            for (int b = 0; b < 2; ++b)
#pragma unroll
                for (int m = 0; m < 4; ++m)
#pragma unroll
                    for (int n = 0; n < 2; ++n) acc[a][b][m][n] = (f32x4){0.f, 0.f, 0.f, 0.f};
        cur = nxt; cA = nA; cB = nB; ++ui;
        if constexpr (ALIGN_EPI) { if (wr == 1) PG8_BAR; }
    }
    PG8_WAIT_V(0);
    if constexpr (!ALIGN_EPI) { if (wr == 0) PG8_BAR; }
    PG8_BAR;
    if constexpr (Epi::AFTER_DRAIN) { E.fused(acc, cur, wr, wc, fr, fq, lds, wid, lane); }
#undef PG8_SA
#undef PG8_SB
#undef PG8_STAGE
#undef PG8_LDA
#undef PG8_LDB
#undef PG8_MMA
#undef PG8_WAIT_V
#undef PG8_WAIT_L
#undef PG8_BAR
#undef PG8_SCHED
}
}


struct SEpiF32 { float* C; int ldc;
    __device__ __forceinline__ void operator()(const f32x2 (&v)[2], int row, int c2, const int (&n0)[2]) const {
        float* p0 = C + (size_t)row * ldc + n0[0] + c2; float* p1 = C + (size_t)row * ldc + n0[1] + c2;
        __hip_atomic_store(p0, v[0].x, __ATOMIC_RELAXED, __HIP_MEMORY_SCOPE_AGENT); __hip_atomic_store(p0 + 1, v[0].y, __ATOMIC_RELAXED, __HIP_MEMORY_SCOPE_AGENT);
        __hip_atomic_store(p1, v[1].x, __ATOMIC_RELAXED, __HIP_MEMORY_SCOPE_AGENT); __hip_atomic_store(p1 + 1, v[1].y, __ATOMIC_RELAXED, __HIP_MEMORY_SCOPE_AGENT); } };
struct SEpiMixIn { bf16_t* P; const float* rs;
    __device__ __forceinline__ void operator()(const f32x2 (&v)[4], int row, int c2, const int (&n0)[4]) const {
        const float s = rs_of(rs, row);
        if (n0[0] >= 1536) { const float s2 = s * s;
#pragma unroll
            for (int t = 0; t < 2; ++t) { const int q = n0[t] - 1536; const f32x2 z = v[t] * v[t + 2] * s2;
                *(unsigned*)(P + (size_t)row * PW + PC_Z + 128 * (q >> 8) + (q & 127) + c2) = pk2(z.x, z.y); } }
        else {
#pragma unroll
            for (int t = 0; t < 4; ++t) { f32x2 x = v[t] * s; if (n0[0] < 512) x = gelu_pk(x); *(unsigned*)(P + (size_t)row * PW + n0[t] + c2) = pk2(x.x, x.y); } }
    } };
template <int NT, int UNR, class EpiS>
__device__ __forceinline__ void small_gemm_item(LAS unsigned char* lds, const bf16_t* A, const bf16_t* Bt, int K, int row0, const int (&n0)[NT], const EpiS& E) {
    const int tid = opaque_tid(), lane = tid & 63, wave = __builtin_amdgcn_readfirstlane(tid >> 6), half = lane >> 5, l32 = lane & 31;
    const int kw = K >> 3, k0 = wave * kw;
    const bf16_t* ap = A + (size_t)(row0 + l32) * K + k0 + 8 * half;
    const bf16_t* bp[NT];
#pragma unroll
    for (int t = 0; t < NT; ++t) bp[t] = Bt + (size_t)(n0[t] + l32) * K + k0 + 8 * half;
    f32x16 acc[NT];
#pragma unroll
    for (int t = 0; t < NT; ++t)
#pragma unroll
        for (int i = 0; i < 16; ++i) acc[t][i] = 0.f;
    const int nks = kw >> 4;
    for (int ks0 = 0; ks0 < nks; ks0 += UNR) {
        bf16x8 af[UNR], bfr[UNR][NT];
#pragma unroll
        for (int u = 0; u < UNR; ++u) { af[u] = *(const bf16x8*)(ap + (ks0 + u) * 16);
#pragma unroll
            for (int t = 0; t < NT; ++t) bfr[u][t] = *(const bf16x8*)(bp[t] + (ks0 + u) * 16); }
#pragma unroll
        for (int u = 0; u < UNR; ++u)
#pragma unroll
            for (int t = 0; t < NT; ++t) acc[t] = MFMA32(af[u], bfr[u][t], acc[t]);
    }
    LAS float* part = (LAS float*)lds;
#pragma unroll
    for (int t = 0; t < NT; ++t)
#pragma unroll
        for (int i = 0; i < 16; ++i) { const int r = (i & 3) + 8 * (i >> 2) + 4 * half; part[((wave * NT + t) * 32 + r) * 32 + l32] = acc[t][i]; }
    __syncthreads();
    { const int r = tid >> 4, c2 = (tid & 15) * 2; f32x2 v[NT];
#pragma unroll
      for (int t = 0; t < NT; ++t) { v[t] = (f32x2){0.f, 0.f};
#pragma unroll
          for (int w = 0; w < 8; ++w) v[t] += *(const LAS f32x2*)(part + ((w * NT + t) * 32 + r) * 32 + c2); }
      E(v, row0 + r, c2, n0); }
    __syncthreads();
}

__device__ __forceinline__ void transpose_item(const float* W, int N, bf16_t* WT, int K, int k0, int n0, int drow0, const float* g, LAS float* scr, int lane) {
    f32x4 tv[16];
    const int rr = lane >> 4, cc = (lane & 15) * 4;
#pragma unroll
    for (int i = 0; i < 16; ++i) tv[i] = __builtin_nontemporal_load((const f32x4*)(W + (size_t)(k0 + 4 * i + rr) * N + n0 + cc));
    if (g) {
#pragma unroll
        for (int i = 0; i < 16; ++i) tv[i] = tv[i] * g[k0 + 4 * i + rr]; }
#pragma unroll
    for (int i = 0; i < 16; ++i) { LAS float* d = scr + (4 * i + rr) * 65 + cc; d[0] = tv[i][0]; d[1] = tv[i][1]; d[2] = tv[i][2]; d[3] = tv[i][3]; }
    LDS_WAIT();
    const int c = lane & 7;
#pragma unroll
    for (int j = 0; j < 8; ++j) { const int n = (lane >> 3) + 8 * j; const LAS float* sp = scr + (8 * c) * 65 + n;
        u32x4 o; o.x = pk2(sp[0 * 65], sp[1 * 65]); o.y = pk2(sp[2 * 65], sp[3 * 65]); o.z = pk2(sp[4 * 65], sp[5 * 65]); o.w = pk2(sp[6 * 65], sp[7 * 65]);
        *(u32x4*)(WT + (size_t)(drow0 + n) * K + k0 + 8 * c) = o; }
    LDS_WAIT();
}

__device__ __forceinline__ void phase_prologue(const Args& a, LAS unsigned char* lds) {
    const int tid = opaque_tid(), lane = tid & 63, wave = __builtin_amdgcn_readfirstlane(tid >> 6), gw = blockIdx.x * 8 + wave, NGW = gridDim.x * 8;
    unsigned char* ws = a.ws;
    LAS float* scr = (LAS float*)(lds + wave * 17408);
    constexpr int I_GU = 16 * 88, I_DN = 44 * 16, I_IN = 16 * 32, I_OUT = 16 * 16;
    constexpr int N_GU = 8 * I_GU, N_DN = 8 * I_DN, N_IN = 4 * I_IN, N_OUT = 4 * I_OUT, NITEMS = N_GU + N_DN + N_IN + N_OUT;
    for (int it = gw; it < NITEMS; it += NGW) {
        int r = it;
        if (r < N_GU) { const int mat = r / I_GU, q = r % I_GU, kb = q / 88, nb = q % 88, l = mat >> 1, f = mat & 1;
            const int n0 = nb * 64, bj = n0 / FF, rr = n0 % FF, drow0 = 256 * (rr / 128) + 128 * bj + (rr % 128);
            transpose_item(a.w_gu + (size_t)mat * DM * NGU, NGU, (bf16_t*)(ws + WS_WGU) + (size_t)mat * NGU * DM, DM, kb * 64, n0, drow0, a.norm_g + (l * 6 + (f ? 4 : 0)) * DM, scr, lane); continue; }
        r -= N_GU;
        if (r < N_DN) { const int mat = r / I_DN, q = r % I_DN, kb = q / 16, nb = q % 16;
            transpose_item(a.w_down + (size_t)mat * FF * DM, DM, (bf16_t*)(ws + WS_WDN) + (size_t)mat * DM * FF, FF, kb * 64, nb * 64, nb * 64, nullptr, scr, lane); continue; }
        r -= N_DN;
        if (r < N_IN) { const int l = r / I_IN, q = r % I_IN, kb = q / 32, nb = q % 32; const int n0 = nb * 64; int drow0 = n0;
            if (n0 >= 1536) { const int c2 = n0 - 1536, bj = c2 / 256, r2 = c2 % 256; drow0 = 1536 + 256 * (r2 / 128) + 128 * bj + (r2 % 128); }
            transpose_item(a.w_in + (size_t)l * DM * NIN, NIN, (bf16_t*)(ws + WS_WIN) + (size_t)l * NIN * DM, DM, kb * 64, n0, drow0, a.norm_g + (l * 6 + 2) * DM, scr, lane); continue; }
        r -= N_IN;
        { const int l = r / I_OUT, q = r % I_OUT, kb = q / 16, nb = q % 16;
            transpose_item(a.w_out + (size_t)l * DM * DM, DM, (bf16_t*)(ws + WS_WOUT) + (size_t)l * DM * DM, DM, kb * 64, nb * 64, nb * 64, a.g_out + l * DM, scr, lane); }
    }
    { bf16_t* WS = (bf16_t*)(ws + WS_WSGU);
      for (int i = gw * 64 + lane; i < 4 * 4 * 128 * 128; i += NGW * 64) { const int s = i & 127, t = (i >> 7) & 127; WS[i] = (s <= t) ? f2bf(a.w_sgu[i]) : (bf16_t)0; } }
    { bf16_t* XB = (bf16_t*)(ws + WS_XB); float* RS = (float*)(ws + WS_RS);
      for (int row = gw; row < T; row += NGW) {
          const float* src = row < TP ? a.x_prompt + (size_t)row * DM : a.x_sample + (size_t)(row - TP) * DM;
          f32x4 v[4]; float s = 0.f;
#pragma unroll
          for (int j = 0; j < 4; ++j) { v[j] = *(const f32x4*)(src + 4 * lane + 256 * j); s += v[j][0] * v[j][0] + v[j][1] * v[j][1] + v[j][2] * v[j][2] + v[j][3] * v[j][3]; }
          s = wave_sum(s);
#pragma unroll
          for (int j = 0; j < 4; ++j) {
              u32x2 w; w.x = pk2(v[j][0], v[j][1]); w.y = pk2(v[j][2], v[j][3]); *(u32x2*)(XB + (size_t)row * DM + 4 * lane + 256 * j) = w; }
          if (lane == 0) *(f32x4*)(RS + (size_t)row * 4) = (f32x4){s, 0.f, 0.f, 0.f};
      } }
}

__device__ __forceinline__ void small_items_done(unsigned* ctl) {
    asm volatile("s_waitcnt vmcnt(0)" ::: "memory");
    __syncthreads();
    if (threadIdx.x == 0) __hip_atomic_fetch_add(ctl + CW_CNTS, 1u, __ATOMIC_RELAXED, __HIP_MEMORY_SCOPE_AGENT);
}
__device__ __forceinline__ void sample_resnorm(const Args& a, const float* g, float coef, unsigned target, bool last) {
    const int tid = opaque_tid(), lane = tid & 63, wave = __builtin_amdgcn_readfirstlane(tid >> 6);
    unsigned* c = (unsigned*)(a.ws + WS_BAR) + CW_CNTS;
    if ((int)blockIdx.x * 8 >= TS) return;
    if (tid == 0) { unsigned sp = 0; while (__hip_atomic_load(c, __ATOMIC_RELAXED, __HIP_MEMORY_SCOPE_AGENT) < target) { __builtin_amdgcn_s_sleep(1); if (++sp > (1u << 24)) break; }
        asm volatile("s_waitcnt vmcnt(0)" ::: "memory"); }
    __syncthreads();
    float* X = a.out; bf16_t* XB = (bf16_t*)(a.ws + WS_XB); float* PS2 = (float*)(a.ws + WS_RS); const float* Dm = (const float*)(a.ws + WS_DM);
    for (int r = blockIdx.x * 8 + wave; r < TS; r += gridDim.x * 8) { const int row = TP + r;
        f32x4 d[4], x[4]; float s = 0.f;
#pragma unroll
        for (int j = 0; j < 4; ++j) { const float* dp = Dm + (size_t)row * DM + 4 * lane + 256 * j;
#pragma unroll
            for (int e = 0; e < 4; ++e) d[j][e] = __hip_atomic_load(dp + e, __ATOMIC_RELAXED, __HIP_MEMORY_SCOPE_AGENT);
            const u32x2 w = *(const u32x2*)(XB + (size_t)row * DM + 4 * lane + 256 * j);
            x[j] = (f32x4){bflo(w.x), bfhi(w.x), bflo(w.y), bfhi(w.y)};
            s += d[j][0] * d[j][0] + d[j][1] * d[j][1] + d[j][2] * d[j][2] + d[j][3] * d[j][3]; }
        s = wave_sum(s);
        const float sc = fast_rsqrt(s * (1.f / DM) + EPS) * coef; float s2 = 0.f;
#pragma unroll
        for (int j = 0; j < 4; ++j) { const f32x4 gv = *(const f32x4*)(g + 4 * lane + 256 * j); x[j] = x[j] + d[j] * gv * sc; s2 += x[j][0] * x[j][0] + x[j][1] * x[j][1] + x[j][2] * x[j][2] + x[j][3] * x[j][3]; }
        s2 = wave_sum(s2);
#pragma unroll
        for (int j = 0; j < 4; ++j) { if (last) *(f32x4*)(X + (size_t)row * DM + 4 * lane + 256 * j) = x[j];
            u32x2 w; w.x = pk2(x[j][0], x[j][1]); w.y = pk2(x[j][2], x[j][3]); *(u32x2*)(XB + (size_t)row * DM + 4 * lane + 256 * j) = w; }
        if (lane == 0) *(f32x4*)(PS2 + (size_t)row * 4) = (f32x4){s2, 0.f, 0.f, 0.f};
    }
}

__device__ __forceinline__ void lds_add(LAS float* p, float v) { __hip_atomic_fetch_add(p, v, __ATOMIC_RELAXED, __HIP_MEMORY_SCOPE_WORKGROUP); }

template <int LG>
__device__ __forceinline__ void rescale_rows(bf16_t* Y, int R0, int c0, float invw, const LAS float* ssq, int tid) {
    constexpr int NCH = 1 << LG, PER = 128 * NCH / 512;
    u32x4 w[PER];
#pragma unroll
    for (int k = 0; k < PER; ++k) { const int i = tid + 512 * k, r = i >> LG, c = i & (NCH - 1);
        const unsigned long long* p = (const unsigned long long*)(Y + (size_t)(R0 + r) * DM + c0 + c * 8);
        const unsigned long long lo = __hip_atomic_load(p, __ATOMIC_RELAXED, __HIP_MEMORY_SCOPE_AGENT), hi = __hip_atomic_load(p + 1, __ATOMIC_RELAXED, __HIP_MEMORY_SCOPE_AGENT);
        w[k].x = (unsigned)lo; w[k].y = (unsigned)(lo >> 32); w[k].z = (unsigned)hi; w[k].w = (unsigned)(hi >> 32); }
#pragma unroll
    for (int k = 0; k < PER; ++k) { const int i = tid + 512 * k, r = i >> LG, c = i & (NCH - 1); const float sc = fast_rsqrt(ssq[r] * invw + EPS);
        u32x4 o; o.x = pk2(bflo(w[k].x) * sc, bfhi(w[k].x) * sc); o.y = pk2(bflo(w[k].y) * sc, bfhi(w[k].y) * sc); o.z = pk2(bflo(w[k].z) * sc, bfhi(w[k].z) * sc); o.w = pk2(bflo(w[k].w) * sc, bfhi(w[k].w) * sc);
        *(u32x4*)(Y + (size_t)(R0 + r) * DM + c0 + c * 8) = o; }
}

__device__ __forceinline__ void mixer_att_item(const Args& a, int l, int b, int nb, LAS unsigned char* lds) {
    const int tid = opaque_tid(), lane = tid & 63, wave = __builtin_amdgcn_readfirstlane(tid >> 6), half = lane >> 5, l32 = lane & 31;
    constexpr int KST = 72, VST = 264;
    LAS bf16_t* Ks = (LAS bf16_t*)lds;
    LAS bf16_t* VT = (LAS bf16_t*)(lds + 2 * 256 * KST * 2);
    LAS float* ssq = (LAS float*)(lds + 2 * 256 * KST * 2 + 2 * 64 * VST * 2);
    LAS float* ssqt = ssq + 1024;
    const bf16_t* P = (const bf16_t*)(a.ws + WS_P); bf16_t* Y = (bf16_t*)(a.ws + WS_Y);
    const int R0 = b * 2048 + nb * 128;
    for (int i = tid; i < 4096; i += 512) {
        const int key = i >> 4, c = i & 15; const long row = (long)R0 - 128 + key;
        const bool ok = (nb > 0) || (key >= 128);
        u32x4 kv = {0u, 0u, 0u, 0u}, vv = {0u, 0u, 0u, 0u};
        if (ok) { kv = *(const u32x4*)(P + (size_t)row * PW + PC_K + c * 8); vv = *(const u32x4*)(P + (size_t)row * PW + PC_VV + c * 8); }
        *(LAS u32x4*)(Ks + ((c >> 3) * 256 + key) * KST + (c & 7) * 8) = kv;
        LAS bf16_t* vt = VT + ((c >> 3) * 64 + (c & 7) * 8) * VST + (key ^ ((c & 7) << 2));
        vt[0 * VST] = (bf16_t)(vv.x & 0xffffu); vt[1 * VST] = (bf16_t)(vv.x >> 16); vt[2 * VST] = (bf16_t)(vv.y & 0xffffu); vt[3 * VST] = (bf16_t)(vv.y >> 16);
        vt[4 * VST] = (bf16_t)(vv.z & 0xffffu); vt[5 * VST] = (bf16_t)(vv.z >> 16); vt[6 * VST] = (bf16_t)(vv.w & 0xffffu); vt[7 * VST] = (bf16_t)(vv.w >> 16);
        if (nb == 15 && key >= 128) {
            float* ok_ = a.out + O_KP + ((size_t)(l * 8 + b) * 128 + (key - 128)) * 128 + c * 8; float* ov_ = a.out + O_VP + ((size_t)(l * 8 + b) * 128 + (key - 128)) * 128 + c * 8;
            *(f32x4*)ok_ = (f32x4){bflo(kv.x), bfhi(kv.x), bflo(kv.y), bfhi(kv.y)}; *(f32x4*)(ok_ + 4) = (f32x4){bflo(kv.z), bfhi(kv.z), bflo(kv.w), bfhi(kv.w)};
            *(f32x4*)ov_ = (f32x4){bflo(vv.x), bfhi(vv.x), bflo(vv.y), bfhi(vv.y)}; *(f32x4*)(ov_ + 4) = (f32x4){bflo(vv.z), bfhi(vv.z), bflo(vv.w), bfhi(vv.w)};
        }
    }
    __syncthreads();
    {
        const int h = wave, kvh = h >> 2;
        const float slope = __builtin_amdgcn_exp2f(-(float)(h + 1));
        const float sink2 = a.sinks[l * 8 + h] * LOG2E, sl2 = slope * LOG2E, b0 = -sl2 * (float)(128 + l32 - 4 * half);
        const LAS bf16_t* Kh = Ks + kvh * 256 * KST; const LAS bf16_t* Vh = VT + kvh * 64 * VST;
        for (int qs = 0; qs < 4; ++qs) {
            const int q = qs * 32 + l32; const size_t row = (size_t)R0 + q;
            bf16x8 qf[4];
#pragma unroll
            for (int ks = 0; ks < 4; ++ks) qf[ks] = *(const bf16x8*)(P + row * PW + PC_Q + h * 64 + ks * 16 + half * 8);
            f32x16 s[5];
#pragma unroll
            for (int kt = 0; kt < 5; ++kt) {
#pragma unroll
                for (int i = 0; i < 16; ++i) s[kt][i] = 0.f;
#pragma unroll
                for (int ks = 0; ks < 4; ++ks) { const bf16x8 kf = *(const LAS bf16x8*)(Kh + ((qs + kt) * 32 + l32) * KST + ks * 16 + half * 8); s[kt] = MFMA32(kf, qf[ks], s[kt]); }
            }
            float mx = NEGF;
#pragma unroll
            for (int kt = 0; kt < 5; ++kt) { const bool tile_ok = (nb > 0) || (qs + kt >= 4);
#pragma unroll
                for (int i = 0; i < 16; ++i) { const int ci = 8 * (i >> 2) + (i & 3);
                    float v = __builtin_fmaf(s[kt][i], 0.125f * LOG2E, __builtin_fmaf(sl2, (float)(32 * kt + ci), b0));
                    bool valid = tile_ok;
                    if (kt == 0) valid = valid && (ci + 4 * half > l32);
                    if (kt == 4) valid = valid && (ci + 4 * half <= l32);
                    v = valid ? v : NEGF; s[kt][i] = v; mx = fmaxf(mx, v); } }
            mx = fmaxf(mx, __shfl_xor(mx, 32)); mx = fmaxf(mx, sink2);
            float sum = 0.f;
#pragma unroll
            for (int kt = 0; kt < 5; ++kt)
#pragma unroll
                for (int i = 0; i < 16; ++i) { const float p = __builtin_amdgcn_exp2f(s[kt][i] - mx); s[kt][i] = p; sum += p; }
            sum += __shfl_xor(sum, 32);
            const float inv = 1.0f / (sum + __builtin_amdgcn_exp2f(sink2 - mx));
            f32x16 o[2];
#pragma unroll
            for (int i = 0; i < 16; ++i) { o[0][i] = 0.f; o[1][i] = 0.f; }
#pragma unroll
            for (int kt = 0; kt < 5; ++kt)
#pragma unroll
                for (int st = 0; st < 2; ++st) {
                    u32x4 pp; pp.x = pk2(s[kt][8 * st + 0], s[kt][8 * st + 1]); pp.y = pk2(s[kt][8 * st + 2], s[kt][8 * st + 3]); pp.z = pk2(s[kt][8 * st + 4], s[kt][8 * st + 5]); pp.w = pk2(s[kt][8 * st + 6], s[kt][8 * st + 7]);
                    const bf16x8 pb = __builtin_bit_cast(bf16x8, pp);
                    const int keyb = (qs + kt) * 32 + 16 * st + 4 * half;
#pragma unroll
                    for (int dt = 0; dt < 2; ++dt) { const int dd = dt * 32 + l32, kb2 = keyb ^ (((dd >> 3) & 7) << 2); const LAS bf16_t* vr = Vh + dd * VST;
                        const s16x4 lo = *(const LAS s16x4*)(vr + kb2), hi = *(const LAS s16x4*)(vr + (kb2 ^ 8));
                        const bf16x8 va = {lo[0], lo[1], lo[2], lo[3], hi[0], hi[1], hi[2], hi[3]};
                        o[dt] = MFMA32(va, pb, o[dt]); }
                }
            float sq = 0.f;
#pragma unroll
            for (int dt = 0; dt < 2; ++dt)
#pragma unroll
                for (int i4 = 0; i4 < 4; ++i4) { const int d0 = dt * 32 + 8 * i4 + 4 * half;
                    const float v0 = o[dt][4 * i4] * inv, v1 = o[dt][4 * i4 + 1] * inv, v2 = o[dt][4 * i4 + 2] * inv, v3 = o[dt][4 * i4 + 3] * inv;
                    sq += v0 * v0 + v1 * v1 + v2 * v2 + v3 * v3;
                    u32x2 w; w.x = pk2(v0, v1); w.y = pk2(v2, v3); *(u32x2*)(Y + row * DM + 256 + h * 64 + d0) = w; }
            sq += __shfl_xor(sq, 32);
            if (half == 0) ssq[h * 128 + q] = sq;
        }
    }
    __syncthreads();
    if (tid < 128) { float t = 0.f;
#pragma unroll
        for (int hh = 0; hh < 8; ++hh) t += ssq[hh * 128 + tid];
        ssqt[tid] = t; }
    asm volatile("s_waitcnt vmcnt(0)" ::: "memory"); __syncthreads();
    rescale_rows<6>(Y, R0, 256, 1.f / 512.f, ssqt, tid);
    __syncthreads();
}

__device__ __forceinline__ void mixer_sgu_item(const Args& a, int l, int b, int nb, LAS unsigned char* lds) {
    const int tid = opaque_tid(), lane = tid & 63, wave = __builtin_amdgcn_readfirstlane(tid >> 6), half = lane >> 5, l32 = lane & 31;
    constexpr int VS = 136;
    LAS bf16_t* vT = (LAS bf16_t*)lds;
    LAS float* ssq = (LAS float*)(lds + 4 * 64 * VS * 2);
    constexpr int YST = 264;
    LAS bf16_t* yaL = (LAS bf16_t*)(lds + 4 * 64 * VS * 2 + 2304);
    const bf16_t* P = (const bf16_t*)(a.ws + WS_P); bf16_t* Y = (bf16_t*)(a.ws + WS_Y); const bf16_t* WSG = (const bf16_t*)(a.ws + WS_WSGU);
    const int R0 = b * 2048 + nb * 128;
    {
        const int s = tid & 127, h = tid >> 7;
        const u32x4* src = (const u32x4*)(P + (size_t)(R0 + s) * PW + PC_V + h * 64);
        float v[64]; float sum = 0.f;
#pragma unroll
        for (int j = 0; j < 8; ++j) { const u32x4 w = src[j]; v[8 * j] = bflo(w.x); v[8 * j + 1] = bfhi(w.x); v[8 * j + 2] = bflo(w.y); v[8 * j + 3] = bfhi(w.y);
            v[8 * j + 4] = bflo(w.z); v[8 * j + 5] = bfhi(w.z); v[8 * j + 6] = bflo(w.w); v[8 * j + 7] = bfhi(w.w); }
#pragma unroll
        for (int d = 0; d < 64; ++d) sum += v[d];
        const float mean = sum * (1.f / 64.f); float var = 0.f;
#pragma unroll
        for (int d = 0; d < 64; ++d) { v[d] -= mean; var += v[d] * v[d]; }
        const float rstd = fast_rsqrt(var * (1.f / 64.f) + EPS);
        const float* gs = a.g_sgu + l * 256 + h * 64;
#pragma unroll
        for (int d = 0; d < 64; ++d) vT[(h * 64 + d) * VS + s] = f2bf(v[d] * rstd * gs[d]);
    }
    __syncthreads();
    {
        const int h = wave >> 1, th = wave & 1;
        for (int tt2 = 0; tt2 < 2; ++tt2) { const int tt = th * 2 + tt2; const int t = tt * 32 + l32; const size_t row = (size_t)R0 + t;
            f32x16 acc[2];
#pragma unroll
            for (int i = 0; i < 16; ++i) { acc[0][i] = 0.f; acc[1][i] = 0.f; }
            const bf16_t* wrow = WSG + ((size_t)(l * 4 + h) * 128 + t) * 128;
            bf16x8 wf[8];
#pragma unroll
            for (int ks = 0; ks < 8; ++ks) wf[ks] = *(const bf16x8*)(wrow + ks * 16 + half * 8);
#pragma unroll
            for (int ks = 0; ks < 8; ++ks) {
#pragma unroll
                for (int dt = 0; dt < 2; ++dt) { const bf16x8 vf = *(const LAS bf16x8*)(vT + (h * 64 + dt * 32 + l32) * VS + ks * 16 + half * 8); acc[dt] = MFMA32(vf, wf[ks], acc[dt]); }
            }
            const float bias = a.b_sgu[l * 512 + h * 128 + t]; float sq = 0.f;
#pragma unroll
            for (int dt = 0; dt < 2; ++dt)
#pragma unroll
                for (int i4 = 0; i4 < 4; ++i4) { const int d0 = dt * 32 + 8 * i4 + 4 * half;
                    const u32x2 uw = *(const u32x2*)(P + row * PW + PC_U + h * 64 + d0);
                    const float v0 = bflo(uw.x) * (acc[dt][4 * i4] + bias), v1 = bfhi(uw.x) * (acc[dt][4 * i4 + 1] + bias), v2 = bflo(uw.y) * (acc[dt][4 * i4 + 2] + bias), v3 = bfhi(uw.y) * (acc[dt][4 * i4 + 3] + bias);
                    sq += v0 * v0 + v1 * v1 + v2 * v2 + v3 * v3;
                    u32x2 w; w.x = pk2(v0, v1); w.y = pk2(v2, v3); *(LAS u32x2*)(yaL + t * YST + h * 64 + d0) = w; }
            sq += __shfl_xor(sq, 32);
            if (half == 0) ssq[h * 128 + t] = sq;
        }
    }
    {
        const int c = 4 * lane;
        const f32x4 w0 = *(const f32x4*)(a.w_conv + (l * 3 + 0) * 256 + c), w1 = *(const f32x4*)(a.w_conv + (l * 3 + 1) * 256 + c), w2 = *(const f32x4*)(a.w_conv + (l * 3 + 2) * 256 + c);
        u32x2 zw[18], gw[16];
        const int t0 = wave * 16, sq0 = nb * 128 + t0; const size_t row0 = (size_t)R0 + t0;
#pragma unroll
        for (int k = 0; k < 18; ++k) { zw[k] = (u32x2){0u, 0u}; if (sq0 + k - 2 >= 0) zw[k] = *(const u32x2*)(P + (row0 + k - 2) * PW + PC_Z + c); }
#pragma unroll
        for (int k = 0; k < 16; ++k) gw[k] = *(const u32x2*)(P + (row0 + k) * PW + PC_GB + c);
#pragma unroll
        for (int k = 0; k < 16; ++k) { const int t = t0 + k; const size_t row = row0 + k;
            const f32x4 za = {bflo(zw[k].x), bfhi(zw[k].x), bflo(zw[k].y), bfhi(zw[k].y)}, zb = {bflo(zw[k + 1].x), bfhi(zw[k + 1].x), bflo(zw[k + 1].y), bfhi(zw[k + 1].y)},
                        zc = {bflo(zw[k + 2].x), bfhi(zw[k + 2].x), bflo(zw[k + 2].y), bfhi(zw[k + 2].y)};
            const f32x4 gb = {bflo(gw[k].x), bfhi(gw[k].x), bflo(gw[k].y), bfhi(gw[k].y)};
            const f32x4 y = gb * (za * w0 + zb * w1 + zc * w2);
            const float ss = wave_sum(y[0] * y[0] + y[1] * y[1] + y[2] * y[2] + y[3] * y[3]); const float sc = fast_rsqrt(ss * (1.f / 256.f) + EPS);
            u32x2 w; w.x = pk2(y[0] * sc, y[1] * sc); w.y = pk2(y[2] * sc, y[3] * sc); *(u32x2*)(Y + row * DM + 768 + c) = w;
            if (nb == 15 && t >= 126) *(f32x4*)(a.out + O_CP + ((size_t)(l * 8 + b) * 2 + (t - 126)) * 256 + c) = zc; }
    }
    __syncthreads();
#pragma unroll
    for (int k = 0; k < 8; ++k) { const int i = tid + 512 * k, r = i >> 5, c = i & 31; const float sc = fast_rsqrt(((ssq[r] + ssq[128 + r]) + (ssq[256 + r] + ssq[384 + r])) * (1.f / 256.f) + EPS);
        const u32x4 w = *(const LAS u32x4*)(yaL + r * YST + c * 8); u32x4 o;
        o.x = pk2(bflo(w.x) * sc, bfhi(w.x) * sc); o.y = pk2(bflo(w.y) * sc, bfhi(w.y) * sc); o.z = pk2(bflo(w.z) * sc, bfhi(w.z) * sc); o.w = pk2(bflo(w.w) * sc, bfhi(w.w) * sc);
        *(u32x4*)(Y + (size_t)(R0 + r) * DM + c * 8) = o; }
    __syncthreads();
}

__device__ __forceinline__ void mixer_sample_item(const Args& a, int l, int b, LAS unsigned char* lds, int part) {
    const int tid = opaque_tid(), lane = tid & 63, wave = __builtin_amdgcn_readfirstlane(tid >> 6);
    LAS float* qS = (LAS float*)lds;
    LAS float* ybS = qS + 2048;
    LAS float* vS = ybS + 2048;
    LAS float* pS = vS + 1024;
    const bf16_t* P = (const bf16_t*)(a.ws + WS_P); bf16_t* Y = (bf16_t*)(a.ws + WS_Y); const bf16_t* WSG = (const bf16_t*)(a.ws + WS_WSGU);
    const size_t R = (size_t)TP + b * 4;
    if (part == 0) { for (int i = tid; i < 2048; i += 512) { const int t = i >> 9, c = i & 511; qS[i] = bf2f(P[(R + t) * PW + PC_Q + c]); } }
    else if (wave < 4) { const int t = wave; float xh[4];
#pragma unroll
        for (int h = 0; h < 4; ++h) xh[h] = bf2f(P[(R + t) * PW + PC_V + h * 64 + lane]);
#pragma unroll
        for (int h = 0; h < 4; ++h) { const float x = xh[h]; const float mean = wave_sum(x) * (1.f / 64.f); const float dx = x - mean;
            const float var = wave_sum(dx * dx) * (1.f / 64.f); const float v = dx * fast_rsqrt(var + EPS) * a.g_sgu[l * 256 + h * 64 + lane];
            vS[t * 256 + h * 64 + lane] = v; a.out[O_SGUV + ((size_t)(l * 128 + b) * 4 + t) * 256 + h * 64 + lane] = v; }
    } else { const int t = wave - 4, c = 4 * lane;
        const f32x4 w0 = *(const f32x4*)(a.w_conv + (l * 3 + 0) * 256 + c), w1 = *(const f32x4*)(a.w_conv + (l * 3 + 1) * 256 + c), w2 = *(const f32x4*)(a.w_conv + (l * 3 + 2) * 256 + c);
        f32x4 zp[3];
#pragma unroll
        for (int j = 0; j < 3; ++j) { const int i = t + j;
            if (i < 2) zp[j] = *(const f32x4*)(a.cache_conv + ((size_t)(l * 128 + b) * 2 + i) * 256 + c);
            else { const u32x2 zw = *(const u32x2*)(P + (R + i - 2) * PW + PC_Z + c); zp[j] = (f32x4){bflo(zw.x), bfhi(zw.x), bflo(zw.y), bfhi(zw.y)}; } }
        const u32x2 gw = *(const u32x2*)(P + (R + t) * PW + PC_GB + c); const f32x4 gb = {bflo(gw.x), bfhi(gw.x), bflo(gw.y), bfhi(gw.y)};
        const f32x4 y = gb * (zp[0] * w0 + zp[1] * w1 + zp[2] * w2);
        const float ss = wave_sum(y[0] * y[0] + y[1] * y[1] + y[2] * y[2] + y[3] * y[3]); const float sc = fast_rsqrt(ss * (1.f / 256.f) + EPS);
        u32x2 w; w.x = pk2(y[0] * sc, y[1] * sc); w.y = pk2(y[2] * sc, y[3] * sc); *(u32x2*)(Y + (R + t) * DM + 768 + c) = w;
        if (t >= 2) *(f32x4*)(a.out + O_CS + ((size_t)(l * 128 + b) * 2 + (t - 2)) * 256 + c) = zp[2];
    }
    __syncthreads();
    if (part == 1 && wave < 4) { const int t = wave; float ya[4]; float ss = 0.f;
#pragma unroll
        for (int h = 0; h < 4; ++h) { float mix = a.b_sgu[l * 512 + h * 128 + t];
#pragma unroll
            for (int s = 0; s < 4; ++s) mix += bf2f(WSG[((size_t)(l * 4 + h) * 128 + t) * 128 + s]) * vS[s * 256 + h * 64 + lane];
            ya[h] = bf2f(P[(R + t) * PW + PC_U + h * 64 + lane]) * mix; ss += ya[h] * ya[h]; }
        ss = wave_sum(ss); const float sc = fast_rsqrt(ss * (1.f / 256.f) + EPS);
#pragma unroll
        for (int h = 0; h < 4; ++h) Y[(R + t) * DM + h * 64 + lane] = f2bf(ya[h] * sc);
    }
    if (part == 0) {
        const int h = wave, kvh = h >> 2;
        const float slope = __builtin_amdgcn_exp2f(-(float)(h + 1)); const float sink = a.sinks[l * 8 + h];
        const float* ck = a.cache_k + (size_t)(l * 128 + b) * 128 * 128 + kvh * 64; const float* cv = a.cache_v + (size_t)(l * 128 + b) * 128 * 128 + kvh * 64;
        float sc[3][4];
#pragma unroll
        for (int j = 0; j < 3; ++j)
#pragma unroll
            for (int t = 0; t < 4; ++t) sc[j][t] = 0.f;
#pragma unroll 1
        for (int hh = 0; hh < 4; ++hh) {
            f32x4 kv0[4], kv1[4]; u32x2 kw[4];
#pragma unroll
            for (int d = 0; d < 4; ++d) { kv0[d] = *(const f32x4*)(ck + (size_t)lane * 128 + (hh * 4 + d) * 4); kv1[d] = *(const f32x4*)(ck + (size_t)(lane + 64) * 128 + (hh * 4 + d) * 4);
                kw[d] = (u32x2){0u, 0u}; if (lane < 4) kw[d] = *(const u32x2*)(P + (R + lane) * PW + PC_K + kvh * 64 + (hh * 4 + d) * 4); }
#pragma unroll
            for (int d = 0; d < 4; ++d)
#pragma unroll
                for (int t = 0; t < 4; ++t) { const f32x4 qv = *(const LAS f32x4*)(qS + t * 512 + h * 64 + (hh * 4 + d) * 4);
                    sc[0][t] += kv0[d][0] * qv[0] + kv0[d][1] * qv[1] + kv0[d][2] * qv[2] + kv0[d][3] * qv[3];
                    sc[1][t] += kv1[d][0] * qv[0] + kv1[d][1] * qv[1] + kv1[d][2] * qv[2] + kv1[d][3] * qv[3];
                    sc[2][t] += bflo(kw[d].x) * qv[0] + bfhi(kw[d].x) * qv[1] + bflo(kw[d].y) * qv[2] + bfhi(kw[d].y) * qv[3]; }
        }
#pragma unroll
        for (int t = 0; t < 4; ++t) { float val[3]; float mx = NEGF;
#pragma unroll
            for (int j = 0; j < 3; ++j) { const int kk = lane + 64 * j, dist = 128 + t - kk; const bool valid = (kk < 132) && (dist >= 0) && (dist < 128);
                val[j] = valid ? sc[j][t] * 0.125f - slope * (float)dist : NEGF; mx = fmaxf(mx, val[j]); }
            mx = fmaxf(wave_max(mx), sink); float sum = 0.f;
#pragma unroll
            for (int j = 0; j < 3; ++j) { val[j] = __builtin_amdgcn_exp2f((val[j] - mx) * LOG2E); sum += val[j]; }
            sum = wave_sum(sum); const float inv = 1.0f / (sum + __builtin_amdgcn_exp2f((sink - mx) * LOG2E));
#pragma unroll
            for (int j = 0; j < 3; ++j) { const int kk = lane + 64 * j; if (kk < 132) pS[(wave * 4 + t) * 136 + kk] = val[j] * inv; }
        }
        LDS_WAIT(); __builtin_amdgcn_wave_barrier();
        { const int d4 = (lane & 15) * 4, kq = lane >> 4;
          f32x4 o[4];
#pragma unroll
          for (int t = 0; t < 4; ++t) o[t] = (f32x4){0.f, 0.f, 0.f, 0.f};
#pragma unroll
          for (int bt = 0; bt < 4; ++bt) { f32x4 vv[8];
#pragma unroll
              for (int i = 0; i < 8; ++i) vv[i] = *(const f32x4*)(cv + (size_t)((bt * 8 + i) * 4 + kq) * 128 + d4);
#pragma unroll
              for (int i = 0; i < 8; ++i)
#pragma unroll
                  for (int t = 0; t < 4; ++t) o[t] += vv[i] * pS[(wave * 4 + t) * 136 + (bt * 8 + i) * 4 + kq];
              asm volatile("" ::: "memory"); }
          { const u32x2 vw = *(const u32x2*)(P + (R + kq) * PW + PC_VV + kvh * 64 + d4); const f32x4 vn = {bflo(vw.x), bfhi(vw.x), bflo(vw.y), bfhi(vw.y)};
#pragma unroll
            for (int t = 0; t < 4; ++t) o[t] += vn * pS[(wave * 4 + t) * 136 + 128 + kq]; }
#pragma unroll
          for (int t = 0; t < 4; ++t)
#pragma unroll
              for (int c = 0; c < 4; ++c) { float x = o[t][c]; x += __shfl_xor(x, 16); x += __shfl_xor(x, 32); o[t][c] = x; }
          if (kq == 0) {
#pragma unroll
              for (int t = 0; t < 4; ++t) *(LAS f32x4*)(ybS + t * 512 + h * 64 + d4) = o[t]; }
        }
    }
    __syncthreads();
    if (part == 0 && wave < 4) { const int t = wave; float v[8]; float ss = 0.f;
#pragma unroll
        for (int j = 0; j < 8; ++j) { v[j] = ybS[t * 512 + lane * 8 + j]; ss += v[j] * v[j]; }
        ss = wave_sum(ss); const float sc = fast_rsqrt(ss * (1.f / 512.f) + EPS);
        u32x4 w; w.x = pk2(v[0] * sc, v[1] * sc); w.y = pk2(v[2] * sc, v[3] * sc); w.z = pk2(v[4] * sc, v[5] * sc); w.w = pk2(v[6] * sc, v[7] * sc);
        *(u32x4*)(Y + (R + t) * DM + 256 + lane * 8) = w;
    }
    if (part == 1) { f32x4 kv[8], vv[8];
#pragma unroll
      for (int k = 0; k < 8; ++k) { const int i = tid + 512 * k, w = i >> 5, c4 = (i & 31) * 4;
          if (w < 124) { kv[k] = *(const f32x4*)(a.cache_k + ((size_t)(l * 128 + b) * 128 + w + 4) * 128 + c4); vv[k] = *(const f32x4*)(a.cache_v + ((size_t)(l * 128 + b) * 128 + w + 4) * 128 + c4); }
          else { const u32x2 kw = *(const u32x2*)(P + (R + w - 124) * PW + PC_K + c4), vw = *(const u32x2*)(P + (R + w - 124) * PW + PC_VV + c4);
              kv[k] = (f32x4){bflo(kw.x), bfhi(kw.x), bflo(kw.y), bfhi(kw.y)}; vv[k] = (f32x4){bflo(vw.x), bfhi(vw.x), bflo(vw.y), bfhi(vw.y)}; } }
#pragma unroll
      for (int k = 0; k < 8; ++k) { const int i = tid + 512 * k, w = i >> 5, c4 = (i & 31) * 4;
          *(f32x4*)(a.out + O_KS + ((size_t)(l * 128 + b) * 128 + w) * 128 + c4) = kv[k]; *(f32x4*)(a.out + O_VS + ((size_t)(l * 128 + b) * 128 + w) * 128 + c4) = vv[k]; } }
    __syncthreads();
}

__global__ void __launch_bounds__(512) mega_fwd(Args a_in) {
#if defined(__HIP_DEVICE_COMPILE__)
    extern __shared__ __attribute__((aligned(16))) unsigned char lds_raw[];
    LAS unsigned char* lds = (LAS unsigned char*)lds_raw;
    cg::grid_group grid = cg::this_grid();
    typedef const __attribute__((address_space(4))) Args* KArgsPtr;
    KArgsPtr ap0 = (KArgsPtr)__builtin_amdgcn_kernarg_segment_ptr();
#define ARGS() ({ KArgsPtr p_ = ap0; asm volatile("" : "+s"(p_)); *p_; })
    const int G = gridDim.x;
    volatile LAS unsigned* bst = (volatile LAS unsigned*)(lds + LDS_BYTES - 16);
    if (threadIdx.x == 0) { bst[0] = 0u; bst[1] = 0u; const Args a = ARGS(); (void)xb_add((unsigned*)(a.ws + WS_BAR) + XB_XCNT(xb_xcc_id()), 1u); }
    __syncthreads();
#define GBAR() do { const Args a_ = ARGS(); xcd_barrier((unsigned*)(a_.ws + WS_BAR), bst); } while (0)
    for (int rep = 0; rep < REP_PRO; ++rep) { const Args a = ARGS(); phase_prologue(a, lds); }
    { const Args a = ARGS(); if (a.ws == nullptr) grid.sync(); }
    GBAR();
    for (int l = 0; l < DEPTH; ++l) {
        for (int step = 0; step < 3; ++step) {
            if (step != 1) {
                const int f = step >> 1, mat = l * 2 + f;
                for (int rep = 0; rep < REP_GEMM; ++rep) { const Args a = ARGS(); unsigned char* ws = a.ws;
                  pg8::Gemm g{(const bf16_t*)(ws + WS_XB), (const bf16_t*)(ws + WS_WGU) + (size_t)mat * NGU * DM, T, NGU, DM}; pg8::StaticOrder S; S.init(T, NGU, G, (int)blockIdx.x);
                  pg8::EpiSwiglu E{(bf16_t*)(ws + WS_ACT), (const float*)(ws + WS_RS)}; pg8::gemm_phase<pg8::EpiSwiglu, true, true>(lds, g, S, E); }
                GBAR();
                { const Args a = ARGS(); unsigned char* ws = a.ws; const int inst = l * 3 + step;
                  pg8::Gemm g{(const bf16_t*)(ws + WS_ACT), (const bf16_t*)(ws + WS_WDN) + (size_t)mat * DM * FF, TP, DM, FF}; pg8::StaticOrder S; S.init(TP, DM, G, (int)blockIdx.x);
                  SEpiF32 SE{(float*)(ws + WS_DM), DM};
                  for (int it = blockIdx.x; it < 256; it += G) { const int n0[2] = {(it & 15) * 64, (it & 15) * 64 + 32}; small_gemm_item<2, 11, SEpiF32>(lds, g.A, g.Bt, FF, TP + (it >> 4) * 32, n0, SE); small_items_done((unsigned*)(ws + WS_BAR)); }
                  const float* gn = a.norm_g + (l * 6 + (f ? 5 : 1)) * DM;
                  const bool last = (inst == 11);
                  pg8::EpiResNorm E{last ? a.out : (float*)nullptr, (bf16_t*)(ws + WS_XB), (float*)(ws + WS_PS1), (float*)(ws + WS_RS), (unsigned*)(ws + WS_BAR), gn, 0.5f, 4u * (unsigned)(inst + 1)};
                  pg8::gemm_phase<pg8::EpiResNorm, false, true>(lds, g, S, E);
                  sample_resnorm(a, gn, 0.5f, 256u * (unsigned)(inst + 1), last); }
                GBAR();
            } else {
                for (int rep = 0; rep < REP_GEMM; ++rep) { const Args a = ARGS(); unsigned char* ws = a.ws;
                  pg8::Gemm g{(const bf16_t*)(ws + WS_XB), (const bf16_t*)(ws + WS_WIN) + (size_t)l * NIN * DM, TP, NIN, DM}; pg8::StaticOrder S; S.init(TP, NIN, G, (int)blockIdx.x);
                  pg8::EpiMixIn E{(bf16_t*)(ws + WS_P), (const float*)(ws + WS_RS)}; pg8::gemm_phase<pg8::EpiMixIn, true, true>(lds, g, S, E);
                  SEpiMixIn SE{(bf16_t*)(ws + WS_P), (const float*)(ws + WS_RS)};
                  for (int it = blockIdx.x; it < 256; it += G) { const int cg_ = it & 15; int n0[4];
                      if (cg_ < 12) { n0[0] = cg_ * 128; n0[1] = n0[0] + 32; n0[2] = n0[0] + 64; n0[3] = n0[0] + 96; }
                      else { const int q = cg_ - 12; n0[0] = 1536 + 256 * (q >> 1) + 64 * (q & 1); n0[1] = n0[0] + 32; n0[2] = n0[0] + 128; n0[3] = n0[0] + 160; }
                      small_gemm_item<4, 8, SEpiMixIn>(lds, g.A, g.Bt, DM, TP + (it >> 4) * 32, n0, SE); } }
                GBAR();
                for (int rep = 0; rep < REP_MIX; ++rep) {
                    for (int it = blockIdx.x; it < 256; it += G) {
                        if (it < 128) { for (int r2 = 0; r2 < REP_ATT; ++r2) { const Args a = ARGS(); mixer_att_item(a, l, it >> 4, it & 15, lds); }
                            for (int r2 = 0; r2 < REP_SMP; ++r2) { const Args a = ARGS(); mixer_sample_item(a, l, it, lds, 1); } }
                        else { for (int r2 = 0; r2 < REP_SGU; ++r2) { const Args a = ARGS(); mixer_sgu_item(a, l, (it - 128) >> 4, (it - 128) & 15, lds); }
                            for (int r2 = 0; r2 < REP_SMP; ++r2) { const Args a = ARGS(); mixer_sample_item(a, l, it - 128, lds, 0); } }
                    }
                }
                GBAR();
                { const Args a = ARGS(); unsigned char* ws = a.ws; const int inst = l * 3 + step;
                  pg8::Gemm g{(const bf16_t*)(ws + WS_Y), (const bf16_t*)(ws + WS_WOUT) + (size_t)l * DM * DM, TP, DM, DM}; pg8::StaticOrder S; S.init(TP, DM, G, (int)blockIdx.x);
                  SEpiF32 SE{(float*)(ws + WS_DM), DM};
                  for (int it = blockIdx.x; it < 256; it += G) { const int n0[2] = {(it & 15) * 64, (it & 15) * 64 + 32}; small_gemm_item<2, 8, SEpiF32>(lds, g.A, g.Bt, DM, TP + (it >> 4) * 32, n0, SE); small_items_done((unsigned*)(ws + WS_BAR)); }
                  const float* gn = a.norm_g + (l * 6 + 3) * DM;
                  pg8::EpiResNorm E{(float*)nullptr, (bf16_t*)(ws + WS_XB), (float*)(ws + WS_PS1), (float*)(ws + WS_RS), (unsigned*)(ws + WS_BAR), gn, 1.0f, 4u * (unsigned)(inst + 1)};
                  pg8::gemm_phase<pg8::EpiResNorm, false, true>(lds, g, S, E);
                  sample_resnorm(a, gn, 1.0f, 256u * (unsigned)(inst + 1), false); }
                GBAR();
            }
        }
    }
#undef GBAR
#undef ARGS
#endif
}

extern "C" void kernel_launch(void* const* d_in, const int* in_sizes, int n_in, void* d_out, int out_size, void* d_ws, size_t ws_size, hipStream_t stream) {
    static int grid_blocks = 0;
    if (!grid_blocks) {
        int dev = 0, cus = 0, per_cu = 0;
        hipGetDevice(&dev);
        hipDeviceGetAttribute(&cus, hipDeviceAttributeMultiprocessorCount, dev);
        hipFuncSetAttribute((const void*)mega_fwd, hipFuncAttributeMaxDynamicSharedMemorySize, LDS_BYTES);
        hipOccupancyMaxActiveBlocksPerMultiprocessor(&per_cu, (const void*)mega_fwd, 512, LDS_BYTES);
        if (per_cu < 1) per_cu = 1;
        grid_blocks = cus * per_cu;
        if (ws_size < WS_END) fprintf(stderr, "kernel_launch: workspace too small (%zu < %zu)\n", ws_size, (size_t)WS_END);
    }
    Args a{};
    a.x_prompt = (const float*)d_in[0]; a.x_sample = (const float*)d_in[1]; a.cache_k = (const float*)d_in[2]; a.cache_v = (const float*)d_in[3]; a.cache_conv = (const float*)d_in[4];
    a.norm_g = (const float*)d_in[5]; a.w_gu = (const float*)d_in[6]; a.w_down = (const float*)d_in[7]; a.w_in = (const float*)d_in[8]; a.w_out = (const float*)d_in[9];
    a.g_out = (const float*)d_in[10]; a.w_sgu = (const float*)d_in[11]; a.b_sgu = (const float*)d_in[12]; a.g_sgu = (const float*)d_in[13]; a.sinks = (const float*)d_in[14]; a.w_conv = (const float*)d_in[15];
    a.out = (float*)d_out; a.ws = (unsigned char*)d_ws;
    hipMemsetAsync((char*)d_ws + WS_BAR, 0, CTL_BYTES, stream);
    void* args[] = {&a};
    hipError_t e = hipLaunchCooperativeKernel((const void*)mega_fwd, dim3(grid_blocks), dim3(512), args, LDS_BYTES, stream);
    if (e != hipSuccess) fprintf(stderr, "cooperative launch failed: %s (grid %d)\n", hipGetErrorString(e), grid_blocks);
}
```

```cpp
#include <hip/hip_runtime.h>
#include <hip/hip_cooperative_groups.h>
#include <cstdio>
namespace cg = cooperative_groups;

#define LAS __attribute__((address_space(3)))
typedef unsigned short bf16_t;
typedef short bf16x8 __attribute__((ext_vector_type(8)));
typedef short s16x4 __attribute__((ext_vector_type(4)));
typedef float f32x2 __attribute__((ext_vector_type(2)));
typedef float f32x4 __attribute__((ext_vector_type(4)));
typedef float f32x16 __attribute__((ext_vector_type(16)));
typedef unsigned u32x2 __attribute__((ext_vector_type(2)));
typedef unsigned u32x4 __attribute__((ext_vector_type(4)));
typedef __bf16 bf16v2 __attribute__((ext_vector_type(2)));

constexpr int TP = 16384, TS = 512, T = TP + TS, DM = 1024, FF = 2816, NGU = 2 * FF, NIN = 2048, PW = 1792, DEPTH = 4;
constexpr float EPS = 1e-6f;
constexpr float NEGF = -1e30f;
constexpr float LOG2E = 1.4426950408889634f;
constexpr int PC_U = 0, PC_V = 256, PC_Q = 512, PC_K = 1024, PC_VV = 1152, PC_GB = 1280, PC_Z = 1536;
constexpr size_t O_SGUV = 17301504, O_KP = 17825792, O_VP = 18350080, O_KS = 18874368, O_VS = 27262976, O_CP = 35651584, O_CS = 35667968;
constexpr size_t WS_XB = 0;
constexpr size_t WS_RS = WS_XB + (size_t)T * DM * 2;
constexpr size_t WS_ACT = WS_RS + (size_t)T * 16;
constexpr size_t WS_DM = WS_ACT + (size_t)T * FF * 2;
constexpr size_t WS_P = WS_DM + (size_t)T * DM * 4;
constexpr size_t WS_Y = WS_P + (size_t)T * PW * 2;
constexpr size_t WS_WGU = WS_Y + (size_t)T * DM * 2;
constexpr size_t WS_WDN = WS_WGU + (size_t)8 * NGU * DM * 2;
constexpr size_t WS_WIN = WS_WDN + (size_t)8 * DM * FF * 2;
constexpr size_t WS_WOUT = WS_WIN + (size_t)4 * NIN * DM * 2;
constexpr size_t WS_WSGU = WS_WOUT + (size_t)4 * DM * DM * 2;
constexpr size_t WS_PS1 = WS_WSGU + (size_t)4 * 4 * 128 * 128 * 2;
constexpr size_t WS_BAR = WS_PS1 + (size_t)TP * 16;
constexpr int CTL_BYTES = 32768;
constexpr size_t WS_END = WS_BAR + CTL_BYTES;
#define CW_CNT(pm) (3584 + 64 * (pm))
#define CW_CNTS (3584 + 64 * 64)
constexpr int LDS_BYTES = 144 * 1024;
#ifndef REP_GEMM
#define REP_GEMM 1
#endif
#ifndef REP_MIX
#define REP_MIX 1
#endif
#ifndef REP_PRO
#define REP_PRO 1
#endif
#ifndef REP_ATT
#define REP_ATT 1
#endif
#ifndef REP_SGU
#define REP_SGU 1
#endif
#ifndef REP_SMP
#define REP_SMP 1
#endif

struct Args {
    const float *x_prompt, *x_sample, *cache_k, *cache_v, *cache_conv, *norm_g, *w_gu, *w_down, *w_in, *w_out, *g_out, *w_sgu, *b_sgu, *g_sgu, *sinks, *w_conv;
    float* out; unsigned char* ws;
};

__device__ __forceinline__ float bf2f(bf16_t b) { return __uint_as_float(((unsigned)b) << 16); }
__device__ __forceinline__ float bflo(unsigned w) { return __uint_as_float(w << 16); }
__device__ __forceinline__ float bfhi(unsigned w) { return __uint_as_float(w & 0xffff0000u); }
__device__ __forceinline__ unsigned pk2(float a, float b) { f32x2 v = {a, b}; bf16v2 r = __builtin_convertvector(v, bf16v2); return __builtin_bit_cast(unsigned, r); }
__device__ __forceinline__ bf16_t f2bf(float a) { return (bf16_t)(pk2(a, 0.f) & 0xffffu); }
__device__ __forceinline__ float wave_sum(float v) {
#pragma unroll
    for (int o = 1; o < 64; o <<= 1) v += __shfl_xor(v, o);
    return v;
}
__device__ __forceinline__ float wave_max(float v) {
#pragma unroll
    for (int o = 1; o < 64; o <<= 1) v = fmaxf(v, __shfl_xor(v, o));
    return v;
}
__device__ __forceinline__ float fast_exp(float x) { return __builtin_amdgcn_exp2f(x * LOG2E); }
__device__ __forceinline__ float fast_rsqrt(float x) { return __builtin_amdgcn_rsqf(x); }
__device__ __forceinline__ float rs_of(const float* ps, int row) { const f32x4 p = *(const f32x4*)(ps + (size_t)row * 4); return fast_rsqrt(((p[0] + p[1]) + (p[2] + p[3])) * (1.f / DM) + EPS); }
#define LDS_WAIT() asm volatile("s_waitcnt lgkmcnt(0)" ::: "memory")
__device__ __forceinline__ int opaque_tid() { int t = threadIdx.x; asm volatile("" : "+v"(t)); return t; }
#define MFMA32(a, b, c) __builtin_amdgcn_mfma_f32_32x32x16_bf16((a), (b), (c), 0, 0, 0)

__device__ __forceinline__ f32x2 gelu_pk(f32x2 v) {
    const f32x2 av = __builtin_elementwise_abs(v), d = av * 0.2316418882f + 1.0f;
    f32x2 t; t.x = __builtin_amdgcn_rcpf(d.x); t.y = __builtin_amdgcn_rcpf(d.y);
    f32x2 q = t * 0.5307027145f + (-0.7265760135f); q = q * t + 0.7107068705f; q = q * t + (-0.142248368f); q = q * t + 0.127414796f; q = q * t;
    const f32x2 s = (v * v) * (-0.72134752044f);
    f32x2 e; e.x = __builtin_amdgcn_exp2f(s.x); e.y = __builtin_amdgcn_exp2f(s.y);
    const f32x2 m = v * (q * e), r = v - m;
    f32x2 o; o.x = v.x < 0.f ? m.x : r.x; o.y = v.y < 0.f ? m.y : r.y; return o;
}
__device__ __forceinline__ f32x4 gelu4(f32x4 v) { f32x2 a = gelu_pk((f32x2){v[0], v[1]}), b = gelu_pk((f32x2){v[2], v[3]}); return (f32x4){a.x, a.y, b.x, b.y}; }
__device__ __forceinline__ float silu1(float x) { return x * __builtin_amdgcn_rcpf(1.0f + __builtin_amdgcn_exp2f(-x * LOG2E)); }


#define XB_TMO      128
#define XB_XCNT(j)  (256  + 64 * (j))
#define XB_XSUB(j)  (1280 + 64 * (j))
#define XB_XGEN(j)  (2304 + 64 * (j))
#define XB_TOP      3328
#define XB_TOPGEN   3392
#define XCD_BAR_WORDS 3456
#define XB_SPIN_CAP (1u << 22)
__device__ __forceinline__ unsigned xb_ld(unsigned* p)              { return __hip_atomic_load(p, __ATOMIC_RELAXED, __HIP_MEMORY_SCOPE_AGENT); }
__device__ __forceinline__ unsigned xb_add(unsigned* p, unsigned v) { return __hip_atomic_fetch_add(p, v, __ATOMIC_RELAXED, __HIP_MEMORY_SCOPE_AGENT); }
__device__ __forceinline__ unsigned xb_xcc_id() { return (unsigned)__builtin_amdgcn_s_getreg((3 << 11) | 20) & 0xFu; }
#define XB_SPIN(cond, bar) do { unsigned _sp = 0; while (cond) { __builtin_amdgcn_s_sleep(1); \
    if ((++_sp & 255u) == 0u) { if (xb_ld(&(bar)[XB_TMO])) break; if (_sp > XB_SPIN_CAP) { atomicAdd(&(bar)[XB_TMO], 1u); break; } } } } while (0)
__device__ __forceinline__ void xcd_barrier_complete(unsigned* bar, unsigned x, unsigned& nloc, unsigned& nx) {
    const unsigned G = gridDim.x * gridDim.y * gridDim.z;
    unsigned sum, cnt, mine, sp = 0u;
    for (;;) {
        sum = 0u; cnt = 0u; mine = 0u;
#pragma unroll
        for (unsigned j = 0; j < 16; ++j) { const unsigned c = xb_ld(&bar[XB_XCNT(j)]); sum += c; cnt += (c > 0u) ? 1u : 0u; mine = (j == x) ? c : mine; }
        if (sum == G) break;
        __builtin_amdgcn_s_sleep(1);
        if ((++sp & 255u) == 0u) { if (xb_ld(&bar[XB_TMO])) break; if (sp > XB_SPIN_CAP) { atomicAdd(&bar[XB_TMO], 1u); break; } }
    }
    nloc = mine > 0u ? mine : 1u; nx = cnt > 0u ? cnt : 1u;
}
__device__ __forceinline__ void xcd_barrier(unsigned* bar, volatile LAS unsigned* st) {
    asm volatile("s_waitcnt vmcnt(0)" ::: "memory");
    __syncthreads();
    if (threadIdx.x == 0) {
        const unsigned x = xb_xcc_id();
        __builtin_amdgcn_s_waitcnt(0);
        unsigned nloc = st[0], nx = st[1];
        if (nloc == 0u) { xcd_barrier_complete(bar, x, nloc, nx); st[0] = nloc; st[1] = nx; }
        const unsigned old = xb_add(&bar[XB_XSUB(x)], 1u);
        const unsigned gen = old / nloc;
        if (old + 1u == (gen + 1u) * nloc) {
            __builtin_amdgcn_fence(__ATOMIC_RELEASE, "agent");
            asm volatile("s_waitcnt vmcnt(0)" ::: "memory");
            const unsigned og = xb_add(&bar[XB_TOP], 1u);
            const unsigned tg = og / nx;
            if (og + 1u == (tg + 1u) * nx) xb_add(&bar[XB_TOPGEN], 1u);
            else XB_SPIN(xb_ld(&bar[XB_TOPGEN]) == tg, bar);
            __builtin_amdgcn_fence(__ATOMIC_ACQUIRE, "agent");
            xb_add(&bar[XB_XGEN(x)], 1u);
            asm volatile("s_waitcnt vmcnt(0)" ::: "memory");
        } else {
            XB_SPIN(xb_ld(&bar[XB_XGEN(x)]) == gen, bar);
            __builtin_amdgcn_fence(__ATOMIC_ACQUIRE, "agent");
            asm volatile("s_waitcnt vmcnt(0)" ::: "memory");
        }
    }
    __syncthreads();
}

namespace pg8 {
constexpr int BM = 256, BK = 64, HALF = 128, HTB = HALF * BK * 2, STAGE_BYTES = 8 * HTB, NXCD = 8, WGM = 8;
__host__ __device__ __forceinline__ int lds_byte(int r, int c) { const int st = (r >> 4) * 2 + (c >> 5), rr = r & 15, cc = c & 31, ob = rr * 64 + cc * 2; return st * 1024 + (ob ^ (((ob >> 9) & 1) << 5)); }
__host__ __device__ __forceinline__ void stage_rc(int b, int& R, int& C) { const int st = b / 1024, sb = b % 1024, swz = sb ^ (((sb >> 9) & 1) << 5); R = (st >> 1) * 16 + swz / 64; C = (st & 1) * 32 + (swz % 64) / 2; }
__host__ __device__ __forceinline__ int perm32(int rho) { const int n = rho >> 4, i = rho & 15; return 8 * (i >> 2) + 4 * n + (i & 3); }
struct Unit { int pm, pn; };
struct Gemm { const bf16_t* A; const bf16_t* Bt; int M, N, K; };
struct StaticOrder {
    int nM, nN, nwg, G, c;
    __device__ void init(int M, int N, int G_, int c_) { nM = M / BM; nN = N / BM; nwg = nM * nN; G = G_; c = c_; }
    __device__ bool next(int i, Unit& u) const {
        const long L = (long)i * G + c; if (L >= nwg) return false;
        int wgid = (int)L; { const int q = nwg / NXCD, r = nwg % NXCD, xcd = wgid % NXCD, off = wgid / NXCD; wgid = (xcd < r ? xcd * (q + 1) : r * (q + 1) + (xcd - r) * q) + off; }
        const int nig = WGM * nN, gid = wgid / nig, fm = gid * WGM, gsz = (nM - fm) < WGM ? (nM - fm) : WGM;
        u.pm = fm + ((wgid % nig) % gsz); u.pn = (wgid % nig) / gsz; return true;
    }
};

struct EpiF32 {
    static constexpr bool PERM = false, AFTER_DRAIN = false;
    float* C; int ldc;
    __device__ __forceinline__ void operator()(const f32x4 (&acc)[2][2][4][2], const Unit& u, int wr, int wc, int fr, int fq) const {
        const int row0 = u.pm * BM + wr * 64 + fr, col0 = u.pn * BM + wc * 32 + 4 * fq;
#pragma unroll
        for (int ai = 0; ai < 2; ++ai)
#pragma unroll
            for (int m = 0; m < 4; ++m) { float* rowp = C + (size_t)(row0 + ai * HALF + m * 16) * ldc + col0;
#pragma unroll
                for (int bj = 0; bj < 2; ++bj)
#pragma unroll
                    for (int n = 0; n < 2; ++n) *(f32x4*)(rowp + bj * HALF + n * 16) = acc[ai][bj][m][n]; }
    }
};
struct EpiSwiglu {
    static constexpr bool PERM = true, AFTER_DRAIN = false;
    bf16_t* O; const float* rs;
    __device__ __forceinline__ void operator()(const f32x4 (&acc)[2][2][4][2], const Unit& u, int wr, int wc, int fr, int fq) const {
        const int row0 = u.pm * BM + wr * 64 + fr, col0 = u.pn * HALF + wc * 32 + 8 * fq;
#pragma unroll
        for (int ai = 0; ai < 2; ++ai)
#pragma unroll
            for (int m = 0; m < 4; ++m) { const int row = row0 + ai * HALF + m * 16; const float s = rs_of(rs, row);
                const float c1 = -s * LOG2E, s2 = s * s; u32x4 w;
#pragma unroll
                for (int n = 0; n < 2; ++n)
#pragma unroll
                    for (int jp = 0; jp < 2; ++jp) { const f32x2 g = {acc[ai][0][m][n][2 * jp], acc[ai][0][m][n][2 * jp + 1]}, up = {acc[ai][1][m][n][2 * jp], acc[ai][1][m][n][2 * jp + 1]};
                        const f32x2 t = g * c1; f32x2 e; e.x = __builtin_amdgcn_exp2f(t.x); e.y = __builtin_amdgcn_exp2f(t.y);
                        const f32x2 d = e + 1.0f; f32x2 r; r.x = __builtin_amdgcn_rcpf(d.x); r.y = __builtin_amdgcn_rcpf(d.y);
                        const f32x2 o = (g * up) * (r * s2);
                        w[2 * n + jp] = pk2(o.x, o.y); }
                *(u32x4*)(O + (size_t)row * FF + col0) = w; }
    }
};
struct EpiMixIn {
    static constexpr bool PERM = true, AFTER_DRAIN = false;
    bf16_t* P; const float* rs;
    __device__ __forceinline__ void operator()(const f32x4 (&acc)[2][2][4][2], const Unit& u, int wr, int wc, int fr, int fq) const {
        const int row0 = u.pm * BM + wr * 64 + fr, pn = u.pn;
        if (pn >= 6) {
            const int col0 = PC_Z + HALF * (pn - 6) + wc * 32 + 8 * fq;
#pragma unroll
            for (int ai = 0; ai < 2; ++ai)
#pragma unroll
                for (int m = 0; m < 4; ++m) { const int row = row0 + ai * HALF + m * 16; const float s = rs_of(rs, row), s2 = s * s;
                    const f32x4 v0 = acc[ai][0][m][0] * acc[ai][1][m][0] * s2, v1 = acc[ai][0][m][1] * acc[ai][1][m][1] * s2;
                    u32x4 w; w.x = pk2(v0[0], v0[1]); w.y = pk2(v0[2], v0[3]); w.z = pk2(v1[0], v1[1]); w.w = pk2(v1[2], v1[3]);
                    *(u32x4*)(P + (size_t)row * PW + col0) = w; }
        } else {
            const int col0 = BM * pn + wc * 32 + 8 * fq;
#pragma unroll
            for (int ai = 0; ai < 2; ++ai)
#pragma unroll
                for (int m = 0; m < 4; ++m) { const int row = row0 + ai * HALF + m * 16; const float s = rs_of(rs, row);
#pragma unroll
                    for (int bj = 0; bj < 2; ++bj) { f32x4 v0 = acc[ai][bj][m][0] * s, v1 = acc[ai][bj][m][1] * s;
                        if (pn < 2) { v0 = gelu4(v0); v1 = gelu4(v1); }
                        u32x4 w; w.x = pk2(v0[0], v0[1]); w.y = pk2(v0[2], v0[3]); w.z = pk2(v1[0], v1[1]); w.w = pk2(v1[2], v1[3]);
                        *(u32x4*)(P + (size_t)row * PW + col0 + bj * HALF) = w; } }
        }
    }
};


struct EpiResNorm {
    static constexpr bool PERM = true, AFTER_DRAIN = true;
    float* Xf; bf16_t* XB; float* PS1; float* PS2; unsigned* cnt; const float* g; float coef; unsigned target;
    __device__ __forceinline__ void fused(const f32x4 (&acc)[2][2][4][2], const Unit& u, int wr, int wc, int fr, int fq, LAS unsigned char* lds, int wid, int lane) const {
        LAS float* tab = (LAS float*)lds;
        LAS float* scl = tab + 1024;
        const int tid = wid * 64 + lane;
#pragma unroll
        for (int ai = 0; ai < 2; ++ai)
#pragma unroll
            for (int m = 0; m < 4; ++m) { float p = 0.f;
#pragma unroll
                for (int bj = 0; bj < 2; ++bj)
#pragma unroll
                    for (int n = 0; n < 2; ++n) { const f32x4 v = acc[ai][bj][m][n]; p += (v[0] * v[0] + v[1] * v[1]) + (v[2] * v[2] + v[3] * v[3]); }
                p += __shfl_xor(p, 16); p += __shfl_xor(p, 32);
                if (fq == 0) tab[(ai * HALF + wr * 64 + m * 16 + fr) * 4 + wc] = p; }
        __syncthreads();
        if (tid < 256) { const f32x4 t4 = *(const LAS f32x4*)(tab + tid * 4);
            __hip_atomic_store(PS1 + (size_t)u.pn * TP + (u.pm * BM + tid), (t4[0] + t4[1]) + (t4[2] + t4[3]), __ATOMIC_RELAXED, __HIP_MEMORY_SCOPE_AGENT); }
        asm volatile("s_waitcnt vmcnt(0)" ::: "memory");
        __syncthreads();
        const int col0 = u.pn * BM + wc * 32 + 8 * fq;
        u32x4 xw[2][4][2];
#pragma unroll
        for (int ai = 0; ai < 2; ++ai)
#pragma unroll
            for (int m = 0; m < 4; ++m)
#pragma unroll
                for (int bj = 0; bj < 2; ++bj) xw[ai][m][bj] = *(const u32x4*)(XB + ((size_t)u.pm * BM + ai * HALF + wr * 64 + m * 16 + fr) * DM + col0 + bj * HALF);
        if (tid == 0) { unsigned* c = cnt + CW_CNT(u.pm);
            __hip_atomic_fetch_add(c, 1u, __ATOMIC_RELAXED, __HIP_MEMORY_SCOPE_AGENT);
            unsigned sp = 0; while (__hip_atomic_load(c, __ATOMIC_RELAXED, __HIP_MEMORY_SCOPE_AGENT) < target) { __builtin_amdgcn_s_sleep(1); if (++sp > (1u << 24)) break; }
            asm volatile("s_waitcnt vmcnt(0)" ::: "memory"); }
        __syncthreads();
        if (tid < 256) { const float* p = PS1 + (u.pm * BM + tid); float t = 0.f;
#pragma unroll
            for (int k = 0; k < 4; ++k) t += __hip_atomic_load(p + (size_t)k * TP, __ATOMIC_RELAXED, __HIP_MEMORY_SCOPE_AGENT);
            scl[tid] = fast_rsqrt(t * (1.f / DM) + EPS) * coef; }
        __syncthreads();
        f32x4 gv[2][2];
#pragma unroll
        for (int bj = 0; bj < 2; ++bj)
#pragma unroll
            for (int n = 0; n < 2; ++n) gv[bj][n] = *(const f32x4*)(g + col0 + bj * HALF + 4 * n);
#pragma unroll
        for (int ai = 0; ai < 2; ++ai)
#pragma unroll
            for (int m = 0; m < 4; ++m) { const int lrow = ai * HALF + wr * 64 + m * 16 + fr; const size_t row = (size_t)u.pm * BM + lrow; const float sc = scl[lrow]; float p2 = 0.f;
#pragma unroll
                for (int bj = 0; bj < 2; ++bj) { const u32x4 w = xw[ai][m][bj];
                    f32x4 x0 = {bflo(w.x), bfhi(w.x), bflo(w.y), bfhi(w.y)}, x1 = {bflo(w.z), bfhi(w.z), bflo(w.w), bfhi(w.w)};
                    x0 = x0 + acc[ai][bj][m][0] * gv[bj][0] * sc; x1 = x1 + acc[ai][bj][m][1] * gv[bj][1] * sc;
                    p2 += ((x0[0] * x0[0] + x0[1] * x0[1]) + (x0[2] * x0[2] + x0[3] * x0[3])) + ((x1[0] * x1[0] + x1[1] * x1[1]) + (x1[2] * x1[2] + x1[3] * x1[3]));
                    u32x4 o; o.x = pk2(x0[0], x0[1]); o.y = pk2(x0[2], x0[3]); o.z = pk2(x1[0], x1[1]); o.w = pk2(x1[2], x1[3]);
                    *(u32x4*)(XB + row * DM + col0 + bj * HALF) = o;
                    if (Xf) { *(f32x4*)(Xf + row * DM + col0 + bj * HALF) = x0; *(f32x4*)(Xf + row * DM + col0 + bj * HALF + 4) = x1; } }
                p2 += __shfl_xor(p2, 16); p2 += __shfl_xor(p2, 32);
                if (fq == 0) tab[lrow * 4 + wc] = p2; }
        __syncthreads();
        if (tid < 256) { const f32x4 t4 = *(const LAS f32x4*)(tab + tid * 4); PS2[(size_t)(u.pm * BM + tid) * 4 + u.pn] = (t4[0] + t4[1]) + (t4[2] + t4[3]); }
        __syncthreads();
    }
};

template <class Epi, bool ALIGN_EPI = false, bool SP2 = false>
__device__ __forceinline__ void gemm_phase(LAS unsigned char* lds, const Gemm g, const StaticOrder& S, const Epi& E) {
    const int tid = opaque_tid(), wid = __builtin_amdgcn_readfirstlane(tid >> 6), lane = tid & 63, wr = wid >> 2, wc = wid & 3, fr = lane & 15, fq = lane >> 4;
    const int K = g.K, nt = K / BK;
    unsigned voffA[2], voffB[2];
#pragma unroll
    for (int i = 0; i < 2; ++i) { int R, C; stage_rc(tid * 16 + i * 8192, R, C); const int Rb = Epi::PERM ? ((R & ~31) + perm32(R & 31)) : R;
        voffA[i] = (unsigned)(R * K + C) * 2u; voffB[i] = (unsigned)(Rb * K + C) * 2u; }
    const size_t kstep = (size_t)(BK * 2);
    const size_t hstep = (size_t)HALF * K * 2;
    const size_t tstep = 2 * hstep;
    const unsigned ldsw = (unsigned)wid * 1024u;
    const int aoff = lds_byte(wr * 64 + fr, fq * 8), boff = lds_byte(wc * 32 + fr, fq * 8);
#define PG8_SA(b, h) (((b) * 2 + (h)) * HTB)
#define PG8_SB(b, h) ((4 + (b) * 2 + (h)) * HTB)
#define PG8_STAGE(bufoff, gbase, voff) do { _Pragma("unroll") for (int _i = 0; _i < 2; ++_i) \
        __builtin_amdgcn_global_load_lds((const unsigned*)((const char*)(gbase) + (voff)[_i]), (LAS unsigned*)(lds + (bufoff) + ldsw + _i * 8192), 16, 0, 0); } while (0)
#define PG8_LDA(dst, b, h) do { _Pragma("unroll") for (int m = 0; m < 4; ++m) _Pragma("unroll") for (int k = 0; k < 2; ++k) dst[m][k] = *(const LAS bf16x8*)(lds + PG8_SA(b, h) + aoff + m * 2048 + k * 1024); } while (0)
#define PG8_LDB(dst, b, h) do { _Pragma("unroll") for (int n = 0; n < 2; ++n) _Pragma("unroll") for (int k = 0; k < 2; ++k) dst[n][k] = *(const LAS bf16x8*)(lds + PG8_SB(b, h) + boff + n * 2048 + k * 1024); } while (0)
#define PG8_MMA(ai, bj, At, Bt) do { __builtin_amdgcn_s_setprio(1); _Pragma("unroll") for (int m = 0; m < 4; ++m) _Pragma("unroll") for (int n = 0; n < 2; ++n) _Pragma("unroll") for (int k = 0; k < 2; ++k) \
        acc[ai][bj][m][n] = __builtin_amdgcn_mfma_f32_16x16x32_bf16(Bt[n][k], At[m][k], acc[ai][bj][m][n], 0, 0, 0); __builtin_amdgcn_s_setprio(0); } while (0)
#define PG8_WAIT_V(n) asm volatile("s_waitcnt vmcnt(" #n ")" ::: "memory")
#define PG8_WAIT_L(n) asm volatile("s_waitcnt lgkmcnt(" #n ")" ::: "memory")
#define PG8_BAR __builtin_amdgcn_s_barrier()
#define PG8_SCHED __builtin_amdgcn_sched_barrier(0)
    Unit cur, nxt; int ui = 0;
    if (!S.next(0, cur)) return;
    f32x4 acc[2][2][4][2];
#pragma unroll
    for (int a = 0; a < 2; ++a)
#pragma unroll
        for (int b = 0; b < 2; ++b)
#pragma unroll
            for (int m = 0; m < 4; ++m)
#pragma unroll
                for (int n = 0; n < 2; ++n) acc[a][b][m][n] = (f32x4){0.f, 0.f, 0.f, 0.f};
    bf16x8 At[4][2], B0[2][2], B1[2][2];
    const char* cA = (const char*)g.A + (size_t)cur.pm * tstep; const char* cB = (const char*)g.Bt + (size_t)cur.pn * tstep;
    if constexpr (SP2) {
        PG8_STAGE(PG8_SB(0, 0), cB, voffB); PG8_STAGE(PG8_SB(0, 1), cB + hstep, voffB); PG8_STAGE(PG8_SA(0, 0), cA, voffA); PG8_STAGE(PG8_SA(0, 1), cA + hstep, voffA);
        if (wr == 1) PG8_BAR;
        PG8_WAIT_V(2); PG8_BAR;
        PG8_STAGE(PG8_SB(1, 0), cB + kstep, voffB); PG8_STAGE(PG8_SA(1, 0), cA + kstep, voffA); PG8_STAGE(PG8_SB(1, 1), cB + hstep + kstep, voffB);
        PG8_WAIT_V(6); PG8_BAR;
    } else {
        PG8_STAGE(PG8_SB(0, 0), cB, voffB); PG8_STAGE(PG8_SA(0, 0), cA, voffA); PG8_STAGE(PG8_SB(0, 1), cB + hstep, voffB); PG8_STAGE(PG8_SA(0, 1), cA + hstep, voffA);
        if (wr == 1) PG8_BAR;
        PG8_WAIT_V(4); PG8_BAR;
        PG8_STAGE(PG8_SB(1, 0), cB + kstep, voffB); PG8_STAGE(PG8_SA(1, 0), cA + kstep, voffA); PG8_STAGE(PG8_SB(1, 1), cB + hstep + kstep, voffB);
        PG8_WAIT_V(6); PG8_BAR;
    }
    for (;;) {
        const bool has_next = S.next(ui + 1, nxt);
        const char* nA = has_next ? (const char*)g.A + (size_t)nxt.pm * tstep : cA; const char* nB = has_next ? (const char*)g.Bt + (size_t)nxt.pn * tstep : cB;
        for (int t = 0; t < nt; t += 2) {
            const bool last = (t == nt - 2);
            const char* a1 = cA + (size_t)(t + 1) * kstep;
            const char* a2 = last ? nA : cA + (size_t)(t + 2) * kstep; const char* b2 = last ? nB : cB + (size_t)(t + 2) * kstep;
            const char* a3 = a2 + kstep; const char* b3 = b2 + kstep;
            if constexpr (SP2) {
            PG8_LDB(B0, 0, 0); PG8_LDB(B1, 0, 1); PG8_SCHED; PG8_LDA(At, 0, 0); PG8_STAGE(PG8_SA(1, 1), a1 + hstep, voffA);
            PG8_WAIT_V(8); PG8_WAIT_L(0); PG8_BAR; PG8_MMA(0, 0, At, B0); PG8_MMA(0, 1, At, B1); PG8_BAR; PG8_SCHED;
            PG8_LDA(At, 0, 1); PG8_STAGE(PG8_SB(0, 0), b2, voffB); PG8_STAGE(PG8_SB(0, 1), b2 + hstep, voffB); PG8_STAGE(PG8_SA(0, 0), a2, voffA);
            PG8_WAIT_V(8); PG8_WAIT_L(0); PG8_BAR; PG8_MMA(1, 0, At, B0); PG8_MMA(1, 1, At, B1); PG8_BAR; PG8_SCHED;
            PG8_LDB(B0, 1, 0); PG8_LDB(B1, 1, 1); PG8_SCHED; PG8_LDA(At, 1, 0); PG8_STAGE(PG8_SA(0, 1), a2 + hstep, voffA);
            PG8_WAIT_V(8); PG8_WAIT_L(0); PG8_BAR; PG8_MMA(0, 0, At, B0); PG8_MMA(0, 1, At, B1); PG8_BAR; PG8_SCHED;
            PG8_LDA(At, 1, 1); PG8_STAGE(PG8_SB(1, 0), b3, voffB); PG8_STAGE(PG8_SB(1, 1), b3 + hstep, voffB); PG8_STAGE(PG8_SA(1, 0), a3, voffA);
            PG8_WAIT_V(8); PG8_WAIT_L(0); PG8_BAR; PG8_MMA(1, 0, At, B0); PG8_MMA(1, 1, At, B1); PG8_BAR; PG8_SCHED;
            } else {
            PG8_LDB(B0, 0, 0); PG8_SCHED; PG8_LDA(At, 0, 0); PG8_STAGE(PG8_SA(1, 1), a1 + hstep, voffA);
            PG8_WAIT_L(8); PG8_BAR; PG8_WAIT_L(0); PG8_MMA(0, 0, At, B0); PG8_BAR; PG8_SCHED;
            PG8_LDB(B1, 0, 1); PG8_STAGE(PG8_SB(0, 0), b2, voffB);
            PG8_BAR; PG8_WAIT_L(0); PG8_MMA(0, 1, At, B1); PG8_BAR;
            PG8_LDA(At, 0, 1); PG8_STAGE(PG8_SA(0, 0), a2, voffA);
            PG8_BAR; PG8_WAIT_L(0); PG8_MMA(1, 0, At, B0); PG8_BAR; PG8_SCHED;
            PG8_STAGE(PG8_SB(0, 1), b2 + hstep, voffB);
            PG8_WAIT_V(6); PG8_BAR; PG8_MMA(1, 1, At, B1); PG8_BAR;
            PG8_LDB(B0, 1, 0); PG8_SCHED; PG8_LDA(At, 1, 0); PG8_STAGE(PG8_SA(0, 1), a2 + hstep, voffA);
            PG8_WAIT_L(8); PG8_BAR; PG8_WAIT_L(0); PG8_MMA(0, 0, At, B0); PG8_BAR; PG8_SCHED;
            PG8_LDB(B1, 1, 1); PG8_STAGE(PG8_SB(1, 0), b3, voffB);
            PG8_BAR; PG8_WAIT_L(0); PG8_MMA(0, 1, At, B1); PG8_BAR;
            PG8_LDA(At, 1, 1); PG8_STAGE(PG8_SA(1, 0), a3, voffA);
            PG8_BAR; PG8_WAIT_L(0); PG8_MMA(1, 0, At, B0); PG8_BAR; PG8_SCHED;
            PG8_STAGE(PG8_SB(1, 1), b3 + hstep, voffB);
            PG8_WAIT_V(6); PG8_BAR; PG8_MMA(1, 1, At, B1); PG8_BAR;
            }
        }
        if constexpr (ALIGN_EPI) { if (wr == 0) PG8_BAR; }
        if constexpr (!Epi::AFTER_DRAIN) { E(acc, cur, wr, wc, fr, fq); }
        if (!has_next) break;
#pragma unroll
        for (int a = 0; a < 2; ++a)
#pragma unroll
            for (int b = 0; b < 2; ++b)
#pragma unroll
                for (int m = 0; m < 4; ++m)
#pragma unroll
                    for (int n = 0; n < 2; ++n) acc[a][b][m][n] = (f32x4){0.f, 0.f, 0.f, 0.f};
        cur = nxt; cA = nA; cB = nB; ++ui;
        if constexpr (ALIGN_EPI) { if (wr == 1) PG8_BAR; }
    }
    PG8_WAIT_V(0);
    if constexpr (!ALIGN_EPI) { if (wr == 0) PG8_BAR; }
    PG8_BAR;
    if constexpr (Epi::AFTER_DRAIN) { E.fused(acc, cur, wr, wc, fr, fq, lds, wid, lane); }
#undef PG8_SA
#undef PG8_SB
#undef PG8_STAGE
#undef PG8_LDA
#undef PG8_LDB
#undef PG8_MMA
#undef PG8_WAIT_V
#undef PG8_WAIT_L
#undef PG8_BAR
#undef PG8_SCHED
}
}


struct SEpiF32 { float* C; int ldc;
    __device__ __forceinline__ void operator()(const f32x2 (&v)[2], int row, int c2, const int (&n0)[2]) const {
        float* p0 = C + (size_t)row * ldc + n0[0] + c2; float* p1 = C + (size_t)row * ldc + n0[1] + c2;
        __hip_atomic_store(p0, v[0].x, __ATOMIC_RELAXED, __HIP_MEMORY_SCOPE_AGENT); __hip_atomic_store(p0 + 1, v[0].y, __ATOMIC_RELAXED, __HIP_MEMORY_SCOPE_AGENT);
        __hip_atomic_store(p1, v[1].x, __ATOMIC_RELAXED, __HIP_MEMORY_SCOPE_AGENT); __hip_atomic_store(p1 + 1, v[1].y, __ATOMIC_RELAXED, __HIP_MEMORY_SCOPE_AGENT); } };
struct SEpiMixIn { bf16_t* P; const float* rs;
    __device__ __forceinline__ void operator()(const f32x2 (&v)[4], int row, int c2, const int (&n0)[4]) const {
        const float s = rs_of(rs, row);
        if (n0[0] >= 1536) { const float s2 = s * s;
#pragma unroll
            for (int t = 0; t < 2; ++t) { const int q = n0[t] - 1536; const f32x2 z = v[t] * v[t + 2] * s2;
                *(unsigned*)(P + (size_t)row * PW + PC_Z + 128 * (q >> 8) + (q & 127) + c2) = pk2(z.x, z.y); } }
        else {
#pragma unroll
            for (int t = 0; t < 4; ++t) { f32x2 x = v[t] * s; if (n0[0] < 512) x = gelu_pk(x); *(unsigned*)(P + (size_t)row * PW + n0[t] + c2) = pk2(x.x, x.y); } }
    } };
template <int NT, int UNR, class EpiS>
__device__ __forceinline__ void small_gemm_item(LAS unsigned char* lds, const bf16_t* A, const bf16_t* Bt, int K, int row0, const int (&n0)[NT], const EpiS& E) {
    const int tid = opaque_tid(), lane = tid & 63, wave = __builtin_amdgcn_readfirstlane(tid >> 6), half = lane >> 5, l32 = lane & 31;
    const int kw = K >> 3, k0 = wave * kw;
    const bf16_t* ap = A + (size_t)(row0 + l32) * K + k0 + 8 * half;
    const bf16_t* bp[NT];
#pragma unroll
    for (int t = 0; t < NT; ++t) bp[t] = Bt + (size_t)(n0[t] + l32) * K + k0 + 8 * half;
    f32x16 acc[NT];
#pragma unroll
    for (int t = 0; t < NT; ++t)
#pragma unroll
        for (int i = 0; i < 16; ++i) acc[t][i] = 0.f;
    const int nks = kw >> 4;
    for (int ks0 = 0; ks0 < nks; ks0 += UNR) {
        bf16x8 af[UNR], bfr[UNR][NT];
#pragma unroll
        for (int u = 0; u < UNR; ++u) { af[u] = *(const bf16x8*)(ap + (ks0 + u) * 16);
#pragma unroll
            for (int t = 0; t < NT; ++t) bfr[u][t] = *(const bf16x8*)(bp[t] + (ks0 + u) * 16); }
#pragma unroll
        for (int u = 0; u < UNR; ++u)
#pragma unroll
            for (int t = 0; t < NT; ++t) acc[t] = MFMA32(af[u], bfr[u][t], acc[t]);
    }
    LAS float* part = (LAS float*)lds;
#pragma unroll
    for (int t = 0; t < NT; ++t)
#pragma unroll
        for (int i = 0; i < 16; ++i) { const int r = (i & 3) + 8 * (i >> 2) + 4 * half; part[((wave * NT + t) * 32 + r) * 32 + l32] = acc[t][i]; }
    __syncthreads();
    { const int r = tid >> 4, c2 = (tid & 15) * 2; f32x2 v[NT];
#pragma unroll
      for (int t = 0; t < NT; ++t) { v[t] = (f32x2){0.f, 0.f};
#pragma unroll
          for (int w = 0; w < 8; ++w) v[t] += *(const LAS f32x2*)(part + ((w * NT + t) * 32 + r) * 32 + c2); }
      E(v, row0 + r, c2, n0); }
    __syncthreads();
}

__device__ __forceinline__ void transpose_item(const float* W, int N, bf16_t* WT, int K, int k0, int n0, int drow0, const float* g, LAS float* scr, int lane) {
    f32x4 tv[16];
    const int rr = lane >> 4, cc = (lane & 15) * 4;
#pragma unroll
    for (int i = 0; i < 16; ++i) tv[i] = __builtin_nontemporal_load((const f32x4*)(W + (size_t)(k0 + 4 * i + rr) * N + n0 + cc));
    if (g) {
#pragma unroll
        for (int i = 0; i < 16; ++i) tv[i] = tv[i] * g[k0 + 4 * i + rr]; }
#pragma unroll
    for (int i = 0; i < 16; ++i) { LAS float* d = scr + (4 * i + rr) * 65 + cc; d[0] = tv[i][0]; d[1] = tv[i][1]; d[2] = tv[i][2]; d[3] = tv[i][3]; }
    LDS_WAIT();
    const int c = lane & 7;
#pragma unroll
    for (int j = 0; j < 8; ++j) { const int n = (lane >> 3) + 8 * j; const LAS float* sp = scr + (8 * c) * 65 + n;
        u32x4 o; o.x = pk2(sp[0 * 65], sp[1 * 65]); o.y = pk2(sp[2 * 65], sp[3 * 65]); o.z = pk2(sp[4 * 65], sp[5 * 65]); o.w = pk2(sp[6 * 65], sp[7 * 65]);
        *(u32x4*)(WT + (size_t)(drow0 + n) * K + k0 + 8 * c) = o; }
    LDS_WAIT();
}

__device__ __forceinline__ void phase_prologue(const Args& a, LAS unsigned char* lds) {
    const int tid = opaque_tid(), lane = tid & 63, wave = __builtin_amdgcn_readfirstlane(tid >> 6), gw = blockIdx.x * 8 + wave, NGW = gridDim.x * 8;
    unsigned char* ws = a.ws;
    LAS float* scr = (LAS float*)(lds + wave * 17408);
    constexpr int I_GU = 16 * 88, I_DN = 44 * 16, I_IN = 16 * 32, I_OUT = 16 * 16;
    constexpr int N_GU = 8 * I_GU, N_DN = 8 * I_DN, N_IN = 4 * I_IN, N_OUT = 4 * I_OUT, NITEMS = N_GU + N_DN + N_IN + N_OUT;
    for (int it = gw; it < NITEMS; it += NGW) {
        int r = it;
        if (r < N_GU) { const int mat = r / I_GU, q = r % I_GU, kb = q / 88, nb = q % 88, l = mat >> 1, f = mat & 1;
            const int n0 = nb * 64, bj = n0 / FF, rr = n0 % FF, drow0 = 256 * (rr / 128) + 128 * bj + (rr % 128);
            transpose_item(a.w_gu + (size_t)mat * DM * NGU, NGU, (bf16_t*)(ws + WS_WGU) + (size_t)mat * NGU * DM, DM, kb * 64, n0, drow0, a.norm_g + (l * 6 + (f ? 4 : 0)) * DM, scr, lane); continue; }
        r -= N_GU;
        if (r < N_DN) { const int mat = r / I_DN, q = r % I_DN, kb = q / 16, nb = q % 16;
            transpose_item(a.w_down + (size_t)mat * FF * DM, DM, (bf16_t*)(ws + WS_WDN) + (size_t)mat * DM * FF, FF, kb * 64, nb * 64, nb * 64, nullptr, scr, lane); continue; }
        r -= N_DN;
        if (r < N_IN) { const int l = r / I_IN, q = r % I_IN, kb = q / 32, nb = q % 32; const int n0 = nb * 64; int drow0 = n0;
            if (n0 >= 1536) { const int c2 = n0 - 1536, bj = c2 / 256, r2 = c2 % 256; drow0 = 1536 + 256 * (r2 / 128) + 128 * bj + (r2 % 128); }
            transpose_item(a.w_in + (size_t)l * DM * NIN, NIN, (bf16_t*)(ws + WS_WIN) + (size_t)l * NIN * DM, DM, kb * 64, n0, drow0, a.norm_g + (l * 6 + 2) * DM, scr, lane); continue; }
        r -= N_IN;
        { const int l = r / I_OUT, q = r % I_OUT, kb = q / 16, nb = q % 16;
            transpose_item(a.w_out + (size_t)l * DM * DM, DM, (bf16_t*)(ws + WS_WOUT) + (size_t)l * DM * DM, DM, kb * 64, nb * 64, nb * 64, a.g_out + l * DM, scr, lane); }
    }
    { bf16_t* WS = (bf16_t*)(ws + WS_WSGU);
      for (int i = gw * 64 + lane; i < 4 * 4 * 128 * 128; i += NGW * 64) { const int s = i & 127, t = (i >> 7) & 127; WS[i] = (s <= t) ? f2bf(a.w_sgu[i]) : (bf16_t)0; } }
    { bf16_t* XB = (bf16_t*)(ws + WS_XB); float* RS = (float*)(ws + WS_RS);
      for (int row = gw; row < T; row += NGW) {
          const float* src = row < TP ? a.x_prompt + (size_t)row * DM : a.x_sample + (size_t)(row - TP) * DM;
          f32x4 v[4]; float s = 0.f;
#pragma unroll
          for (int j = 0; j < 4; ++j) { v[j] = *(const f32x4*)(src + 4 * lane + 256 * j); s += v[j][0] * v[j][0] + v[j][1] * v[j][1] + v[j][2] * v[j][2] + v[j][3] * v[j][3]; }
          s = wave_sum(s);
#pragma unroll
          for (int j = 0; j < 4; ++j) {
              u32x2 w; w.x = pk2(v[j][0], v[j][1]); w.y = pk2(v[j][2], v[j][3]); *(u32x2*)(XB + (size_t)row * DM + 4 * lane + 256 * j) = w; }
          if (lane == 0) *(f32x4*)(RS + (size_t)row * 4) = (f32x4){s, 0.f, 0.f, 0.f};
      } }
}

__device__ __forceinline__ void small_items_done(unsigned* ctl) {
    asm volatile("s_waitcnt vmcnt(0)" ::: "memory");
    __syncthreads();
    if (threadIdx.x == 0) __hip_atomic_fetch_add(ctl + CW_CNTS, 1u, __ATOMIC_RELAXED, __HIP_MEMORY_SCOPE_AGENT);
}
__device__ __forceinline__ void sample_resnorm(const Args& a, const float* g, float coef, unsigned target, bool last) {
    const int tid = opaque_tid(), lane = tid & 63, wave = __builtin_amdgcn_readfirstlane(tid >> 6);
    unsigned* c = (unsigned*)(a.ws + WS_BAR) + CW_CNTS;
    if ((int)blockIdx.x * 8 >= TS) return;
    if (tid == 0) { unsigned sp = 0; while (__hip_atomic_load(c, __ATOMIC_RELAXED, __HIP_MEMORY_SCOPE_AGENT) < target) { __builtin_amdgcn_s_sleep(1); if (++sp > (1u << 24)) break; }
        asm volatile("s_waitcnt vmcnt(0)" ::: "memory"); }
    __syncthreads();
    float* X = a.out; bf16_t* XB = (bf16_t*)(a.ws + WS_XB); float* PS2 = (float*)(a.ws + WS_RS); const float* Dm = (const float*)(a.ws + WS_DM);
    for (int r = blockIdx.x * 8 + wave; r < TS; r += gridDim.x * 8) { const int row = TP + r;
        f32x4 d[4], x[4]; float s = 0.f;
#pragma unroll
        for (int j = 0; j < 4; ++j) { const float* dp = Dm + (size_t)row * DM + 4 * lane + 256 * j;
#pragma unroll
            for (int e = 0; e < 4; ++e) d[j][e] = __hip_atomic_load(dp + e, __ATOMIC_RELAXED, __HIP_MEMORY_SCOPE_AGENT);
            const u32x2 w = *(const u32x2*)(XB + (size_t)row * DM + 4 * lane + 256 * j);
            x[j] = (f32x4){bflo(w.x), bfhi(w.x), bflo(w.y), bfhi(w.y)};
            s += d[j][0] * d[j][0] + d[j][1] * d[j][1] + d[j][2] * d[j][2] + d[j][3] * d[j][3]; }
        s = wave_sum(s);
        const float sc = fast_rsqrt(s * (1.f / DM) + EPS) * coef; float s2 = 0.f;
#pragma unroll
        for (int j = 0; j < 4; ++j) { const f32x4 gv = *(const f32x4*)(g + 4 * lane + 256 * j); x[j] = x[j] + d[j] * gv * sc; s2 += x[j][0] * x[j][0] + x[j][1] * x[j][1] + x[j][2] * x[j][2] + x[j][3] * x[j][3]; }
        s2 = wave_sum(s2);
#pragma unroll
        for (int j = 0; j < 4; ++j) { if (last) *(f32x4*)(X + (size_t)row * DM + 4 * lane + 256 * j) = x[j];
            u32x2 w; w.x = pk2(x[j][0], x[j][1]); w.y = pk2(x[j][2], x[j][3]); *(u32x2*)(XB + (size_t)row * DM + 4 * lane + 256 * j) = w; }
        if (lane == 0) *(f32x4*)(PS2 + (size_t)row * 4) = (f32x4){s2, 0.f, 0.f, 0.f};
    }
}

__device__ __forceinline__ void lds_add(LAS float* p, float v) { __hip_atomic_fetch_add(p, v, __ATOMIC_RELAXED, __HIP_MEMORY_SCOPE_WORKGROUP); }

template <int LG>
__device__ __forceinline__ void rescale_rows(bf16_t* Y, int R0, int c0, float invw, const LAS float* ssq, int tid) {
    constexpr int NCH = 1 << LG, PER = 128 * NCH / 512;
    u32x4 w[PER];
#pragma unroll
    for (int k = 0; k < PER; ++k) { const int i = tid + 512 * k, r = i >> LG, c = i & (NCH - 1);
        const unsigned long long* p = (const unsigned long long*)(Y + (size_t)(R0 + r) * DM + c0 + c * 8);
        const unsigned long long lo = __hip_atomic_load(p, __ATOMIC_RELAXED, __HIP_MEMORY_SCOPE_AGENT), hi = __hip_atomic_load(p + 1, __ATOMIC_RELAXED, __HIP_MEMORY_SCOPE_AGENT);
        w[k].x = (unsigned)lo; w[k].y = (unsigned)(lo >> 32); w[k].z = (unsigned)hi; w[k].w = (unsigned)(hi >> 32); }
#pragma unroll
    for (int k = 0; k < PER; ++k) { const int i = tid + 512 * k, r = i >> LG, c = i & (NCH - 1); const float sc = fast_rsqrt(ssq[r] * invw + EPS);
        u32x4 o; o.x = pk2(bflo(w[k].x) * sc, bfhi(w[k].x) * sc); o.y = pk2(bflo(w[k].y) * sc, bfhi(w[k].y) * sc); o.z = pk2(bflo(w[k].z) * sc, bfhi(w[k].z) * sc); o.w = pk2(bflo(w[k].w) * sc, bfhi(w[k].w) * sc);
        *(u32x4*)(Y + (size_t)(R0 + r) * DM + c0 + c * 8) = o; }
}

__device__ __forceinline__ void mixer_att_item(const Args& a, int l, int b, int nb, LAS unsigned char* lds) {
    const int tid = opaque_tid(), lane = tid & 63, wave = __builtin_amdgcn_readfirstlane(tid >> 6), half = lane >> 5, l32 = lane & 31;
    constexpr int KST = 72, VST = 264;
    LAS bf16_t* Ks = (LAS bf16_t*)lds;
    LAS bf16_t* VT = (LAS bf16_t*)(lds + 2 * 256 * KST * 2);
    LAS float* ssq = (LAS float*)(lds + 2 * 256 * KST * 2 + 2 * 64 * VST * 2);
    LAS float* ssqt = ssq + 1024;
    const bf16_t* P = (const bf16_t*)(a.ws + WS_P); bf16_t* Y = (bf16_t*)(a.ws + WS_Y);
    const int R0 = b * 2048 + nb * 128;
    for (int i = tid; i < 4096; i += 512) {
        const int key = i >> 4, c = i & 15; const long row = (long)R0 - 128 + key;
        const bool ok = (nb > 0) || (key >= 128);
        u32x4 kv = {0u, 0u, 0u, 0u}, vv = {0u, 0u, 0u, 0u};
        if (ok) { kv = *(const u32x4*)(P + (size_t)row * PW + PC_K + c * 8); vv = *(const u32x4*)(P + (size_t)row * PW + PC_VV + c * 8); }
        *(LAS u32x4*)(Ks + ((c >> 3) * 256 + key) * KST + (c & 7) * 8) = kv;
        LAS bf16_t* vt = VT + ((c >> 3) * 64 + (c & 7) * 8) * VST + (key ^ ((c & 7) << 2));
        vt[0 * VST] = (bf16_t)(vv.x & 0xffffu); vt[1 * VST] = (bf16_t)(vv.x >> 16); vt[2 * VST] = (bf16_t)(vv.y & 0xffffu); vt[3 * VST] = (bf16_t)(vv.y >> 16);
        vt[4 * VST] = (bf16_t)(vv.z & 0xffffu); vt[5 * VST] = (bf16_t)(vv.z >> 16); vt[6 * VST] = (bf16_t)(vv.w & 0xffffu); vt[7 * VST] = (bf16_t)(vv.w >> 16);
        if (nb == 15 && key >= 128) {
            float* ok_ = a.out + O_KP + ((size_t)(l * 8 + b) * 128 + (key - 128)) * 128 + c * 8; float* ov_ = a.out + O_VP + ((size_t)(l * 8 + b) * 128 + (key - 128)) * 128 + c * 8;
            *(f32x4*)ok_ = (f32x4){bflo(kv.x), bfhi(kv.x), bflo(kv.y), bfhi(kv.y)}; *(f32x4*)(ok_ + 4) = (f32x4){bflo(kv.z), bfhi(kv.z), bflo(kv.w), bfhi(kv.w)};
            *(f32x4*)ov_ = (f32x4){bflo(vv.x), bfhi(vv.x), bflo(vv.y), bfhi(vv.y)}; *(f32x4*)(ov_ + 4) = (f32x4){bflo(vv.z), bfhi(vv.z), bflo(vv.w), bfhi(vv.w)};
        }
    }
    __syncthreads();
    {
        const int h = wave, kvh = h >> 2;
        const float slope = __builtin_amdgcn_exp2f(-(float)(h + 1));
        const float sink2 = a.sinks[l * 8 + h] * LOG2E, sl2 = slope * LOG2E, b0 = -sl2 * (float)(128 + l32 - 4 * half);
        const LAS bf16_t* Kh = Ks + kvh * 256 * KST; const LAS bf16_t* Vh = VT + kvh * 64 * VST;
        for (int qs = 0; qs < 4; ++qs) {
            const int q = qs * 32 + l32; const size_t row = (size_t)R0 + q;
            bf16x8 qf[4];
#pragma unroll
            for (int ks = 0; ks < 4; ++ks) qf[ks] = *(const bf16x8*)(P + row * PW + PC_Q + h * 64 + ks * 16 + half * 8);
            f32x16 s[5];
#pragma unroll
            for (int kt = 0; kt < 5; ++kt) {
#pragma unroll
                for (int i = 0; i < 16; ++i) s[kt][i] = 0.f;
#pragma unroll
                for (int ks = 0; ks < 4; ++ks) { const bf16x8 kf = *(const LAS bf16x8*)(Kh + ((qs + kt) * 32 + l32) * KST + ks * 16 + half * 8); s[kt] = MFMA32(kf, qf[ks], s[kt]); }
            }
            float mx = NEGF;
#pragma unroll
            for (int kt = 0; kt < 5; ++kt) { const bool tile_ok = (nb > 0) || (qs + kt >= 4);
#pragma unroll
                for (int i = 0; i < 16; ++i) { const int ci = 8 * (i >> 2) + (i & 3);
                    float v = __builtin_fmaf(s[kt][i], 0.125f * LOG2E, __builtin_fmaf(sl2, (float)(32 * kt + ci), b0));
                    bool valid = tile_ok;
                    if (kt == 0) valid = valid && (ci + 4 * half > l32);
                    if (kt == 4) valid = valid && (ci + 4 * half <= l32);
                    v = valid ? v : NEGF; s[kt][i] = v; mx = fmaxf(mx, v); } }
            mx = fmaxf(mx, __shfl_xor(mx, 32)); mx = fmaxf(mx, sink2);
            float sum = 0.f;
#pragma unroll
            for (int kt = 0; kt < 5; ++kt)
#pragma unroll
                for (int i = 0; i < 16; ++i) { const float p = __builtin_amdgcn_exp2f(s[kt][i] - mx); s[kt][i] = p; sum += p; }
            sum += __shfl_xor(sum, 32);
            const float inv = 1.0f / (sum + __builtin_amdgcn_exp2f(sink2 - mx));
            f32x16 o[2];
#pragma unroll
            for (int i = 0; i < 16; ++i) { o[0][i] = 0.f; o[1][i] = 0.f; }
#pragma unroll
            for (int kt = 0; kt < 5; ++kt)
#pragma unroll
                for (int st = 0; st < 2; ++st) {
                    u32x4 pp; pp.x = pk2(s[kt][8 * st + 0], s[kt][8 * st + 1]); pp.y = pk2(s[kt][8 * st + 2], s[kt][8 * st + 3]); pp.z = pk2(s[kt][8 * st + 4], s[kt][8 * st + 5]); pp.w = pk2(s[kt][8 * st + 6], s[kt][8 * st + 7]);
                    const bf16x8 pb = __builtin_bit_cast(bf16x8, pp);
                    const int keyb = (qs + kt) * 32 + 16 * st + 4 * half;
#pragma unroll
                    for (int dt = 0; dt < 2; ++dt) { const int dd = dt * 32 + l32, kb2 = keyb ^ (((dd >> 3) & 7) << 2); const LAS bf16_t* vr = Vh + dd * VST;
                        const s16x4 lo = *(const LAS s16x4*)(vr + kb2), hi = *(const LAS s16x4*)(vr + (kb2 ^ 8));
                        const bf16x8 va = {lo[0], lo[1], lo[2], lo[3], hi[0], hi[1], hi[2], hi[3]};
                        o[dt] = MFMA32(va, pb, o[dt]); }
                }
            float sq = 0.f;
#pragma unroll
            for (int dt = 0; dt < 2; ++dt)
#pragma unroll
                for (int i4 = 0; i4 < 4; ++i4) { const int d0 = dt * 32 + 8 * i4 + 4 * half;
                    const float v0 = o[dt][4 * i4] * inv, v1 = o[dt][4 * i4 + 1] * inv, v2 = o[dt][4 * i4 + 2] * inv, v3 = o[dt][4 * i4 + 3] * inv;
                    sq += v0 * v0 + v1 * v1 + v2 * v2 + v3 * v3;
                    u32x2 w; w.x = pk2(v0, v1); w.y = pk2(v2, v3); *(u32x2*)(Y + row * DM + 256 + h * 64 + d0) = w; }
            sq += __shfl_xor(sq, 32);
            if (half == 0) ssq[h * 128 + q] = sq;
        }
    }
    __syncthreads();
    if (tid < 128) { float t = 0.f;
#pragma unroll
        for (int hh = 0; hh < 8; ++hh) t += ssq[hh * 128 + tid];
        ssqt[tid] = t; }
    asm volatile("s_waitcnt vmcnt(0)" ::: "memory"); __syncthreads();
    rescale_rows<6>(Y, R0, 256, 1.f / 512.f, ssqt, tid);
    __syncthreads();
}

__device__ __forceinline__ void mixer_sgu_item(const Args& a, int l, int b, int nb, LAS unsigned char* lds) {
    const int tid = opaque_tid(), lane = tid & 63, wave = __builtin_amdgcn_readfirstlane(tid >> 6), half = lane >> 5, l32 = lane & 31;
    constexpr int VS = 136;
    LAS bf16_t* vT = (LAS bf16_t*)lds;
    LAS float* ssq = (LAS float*)(lds + 4 * 64 * VS * 2);
    constexpr int YST = 264;
    LAS bf16_t* yaL = (LAS bf16_t*)(lds + 4 * 64 * VS * 2 + 2304);
    const bf16_t* P = (const bf16_t*)(a.ws + WS_P); bf16_t* Y = (bf16_t*)(a.ws + WS_Y); const bf16_t* WSG = (const bf16_t*)(a.ws + WS_WSGU);
    const int R0 = b * 2048 + nb * 128;
    {
        const int s = tid & 127, h = tid >> 7;
        const u32x4* src = (const u32x4*)(P + (size_t)(R0 + s) * PW + PC_V + h * 64);
        float v[64]; float sum = 0.f;
#pragma unroll
        for (int j = 0; j < 8; ++j) { const u32x4 w = src[j]; v[8 * j] = bflo(w.x); v[8 * j + 1] = bfhi(w.x); v[8 * j + 2] = bflo(w.y); v[8 * j + 3] = bfhi(w.y);
            v[8 * j + 4] = bflo(w.z); v[8 * j + 5] = bfhi(w.z); v[8 * j + 6] = bflo(w.w); v[8 * j + 7] = bfhi(w.w); }
#pragma unroll
        for (int d = 0; d < 64; ++d) sum += v[d];
        const float mean = sum * (1.f / 64.f); float var = 0.f;
#pragma unroll
        for (int d = 0; d < 64; ++d) { v[d] -= mean; var += v[d] * v[d]; }
        const float rstd = fast_rsqrt(var * (1.f / 64.f) + EPS);
        const float* gs = a.g_sgu + l * 256 + h * 64;
#pragma unroll
        for (int d = 0; d < 64; ++d) vT[(h * 64 + d) * VS + s] = f2bf(v[d] * rstd * gs[d]);
    }
    __syncthreads();
    {
        const int h = wave >> 1, th = wave & 1;
        for (int tt2 = 0; tt2 < 2; ++tt2) { const int tt = th * 2 + tt2; const int t = tt * 32 + l32; const size_t row = (size_t)R0 + t;
            f32x16 acc[2];
#pragma unroll
            for (int i = 0; i < 16; ++i) { acc[0][i] = 0.f; acc[1][i] = 0.f; }
            const bf16_t* wrow = WSG + ((size_t)(l * 4 + h) * 128 + t) * 128;
            bf16x8 wf[8];
#pragma unroll
            for (int ks = 0; ks < 8; ++ks) wf[ks] = *(const bf16x8*)(wrow + ks * 16 + half * 8);
#pragma unroll
            for (int ks = 0; ks < 8; ++ks) {
#pragma unroll
                for (int dt = 0; dt < 2; ++dt) { const bf16x8 vf = *(const LAS bf16x8*)(vT + (h * 64 + dt * 32 + l32) * VS + ks * 16 + half * 8); acc[dt] = MFMA32(vf, wf[ks], acc[dt]); }
            }
            const float bias = a.b_sgu[l * 512 + h * 128 + t]; float sq = 0.f;
#pragma unroll
            for (int dt = 0; dt < 2; ++dt)
#pragma unroll
                for (int i4 = 0; i4 < 4; ++i4) { const int d0 = dt * 32 + 8 * i4 + 4 * half;
                    const u32x2 uw = *(const u32x2*)(P + row * PW + PC_U + h * 64 + d0);
                    const float v0 = bflo(uw.x) * (acc[dt][4 * i4] + bias), v1 = bfhi(uw.x) * (acc[dt][4 * i4 + 1] + bias), v2 = bflo(uw.y) * (acc[dt][4 * i4 + 2] + bias), v3 = bfhi(uw.y) * (acc[dt][4 * i4 + 3] + bias);
                    sq += v0 * v0 + v1 * v1 + v2 * v2 + v3 * v3;
                    u32x2 w; w.x = pk2(v0, v1); w.y = pk2(v2, v3); *(LAS u32x2*)(yaL + t * YST + h * 64 + d0) = w; }
            sq += __shfl_xor(sq, 32);
            if (half == 0) ssq[h * 128 + t] = sq;
        }
    }
    {
        const int c = 4 * lane;
        const f32x4 w0 = *(const f32x4*)(a.w_conv + (l * 3 + 0) * 256 + c), w1 = *(const f32x4*)(a.w_conv + (l * 3 + 1) * 256 + c), w2 = *(const f32x4*)(a.w_conv + (l * 3 + 2) * 256 + c);
        u32x2 zw[18], gw[16];
        const int t0 = wave * 16, sq0 = nb * 128 + t0; const size_t row0 = (size_t)R0 + t0;
#pragma unroll
        for (int k = 0; k < 18; ++k) { zw[k] = (u32x2){0u, 0u}; if (sq0 + k - 2 >= 0) zw[k] = *(const u32x2*)(P + (row0 + k - 2) * PW + PC_Z + c); }
#pragma unroll
        for (int k = 0; k < 16; ++k) gw[k] = *(const u32x2*)(P + (row0 + k) * PW + PC_GB + c);
#pragma unroll
        for (int k = 0; k < 16; ++k) { const int t = t0 + k; const size_t row = row0 + k;
            const f32x4 za = {bflo(zw[k].x), bfhi(zw[k].x), bflo(zw[k].y), bfhi(zw[k].y)}, zb = {bflo(zw[k + 1].x), bfhi(zw[k + 1].x), bflo(zw[k + 1].y), bfhi(zw[k + 1].y)},
                        zc = {bflo(zw[k + 2].x), bfhi(zw[k + 2].x), bflo(zw[k + 2].y), bfhi(zw[k + 2].y)};
            const f32x4 gb = {bflo(gw[k].x), bfhi(gw[k].x), bflo(gw[k].y), bfhi(gw[k].y)};
            const f32x4 y = gb * (za * w0 + zb * w1 + zc * w2);
            const float ss = wave_sum(y[0] * y[0] + y[1] * y[1] + y[2] * y[2] + y[3] * y[3]); const float sc = fast_rsqrt(ss * (1.f / 256.f) + EPS);
            u32x2 w; w.x = pk2(y[0] * sc, y[1] * sc); w.y = pk2(y[2] * sc, y[3] * sc); *(u32x2*)(Y + row * DM + 768 + c) = w;
            if (nb == 15 && t >= 126) *(f32x4*)(a.out + O_CP + ((size_t)(l * 8 + b) * 2 + (t - 126)) * 256 + c) = zc; }
    }
    __syncthreads();
#pragma unroll
    for (int k = 0; k < 8; ++k) { const int i = tid + 512 * k, r = i >> 5, c = i & 31; const float sc = fast_rsqrt(((ssq[r] + ssq[128 + r]) + (ssq[256 + r] + ssq[384 + r])) * (1.f / 256.f) + EPS);
        const u32x4 w = *(const LAS u32x4*)(yaL + r * YST + c * 8); u32x4 o;
        o.x = pk2(bflo(w.x) * sc, bfhi(w.x) * sc); o.y = pk2(bflo(w.y) * sc, bfhi(w.y) * sc); o.z = pk2(bflo(w.z) * sc, bfhi(w.z) * sc); o.w = pk2(bflo(w.w) * sc, bfhi(w.w) * sc);
        *(u32x4*)(Y + (size_t)(R0 + r) * DM + c * 8) = o; }
    __syncthreads();
}

__device__ __forceinline__ void mixer_sample_item(const Args& a, int l, int b, LAS unsigned char* lds) {
    const int tid = opaque_tid(), lane = tid & 63, wave = __builtin_amdgcn_readfirstlane(tid >> 6);
    LAS float* qS = (LAS float*)lds;
    LAS float* ybS = qS + 2048;
    LAS float* vS = ybS + 2048;
    LAS float* pS = vS + 1024;
    const bf16_t* P = (const bf16_t*)(a.ws + WS_P); bf16_t* Y = (bf16_t*)(a.ws + WS_Y); const bf16_t* WSG = (const bf16_t*)(a.ws + WS_WSGU);
    const size_t R = (size_t)TP + b * 4;
    for (int i = tid; i < 2048; i += 512) { const int t = i >> 9, c = i & 511; qS[i] = bf2f(P[(R + t) * PW + PC_Q + c]); }
    if (wave < 4) { const int t = wave;
        for (int h = 0; h < 4; ++h) { const float x = bf2f(P[(R + t) * PW + PC_V + h * 64 + lane]); const float mean = wave_sum(x) * (1.f / 64.f); const float dx = x - mean;
            const float var = wave_sum(dx * dx) * (1.f / 64.f); const float v = dx * fast_rsqrt(var + EPS) * a.g_sgu[l * 256 + h * 64 + lane];
            vS[t * 256 + h * 64 + lane] = v; a.out[O_SGUV + ((size_t)(l * 128 + b) * 4 + t) * 256 + h * 64 + lane] = v; }
    } else { const int t = wave - 4, c = 4 * lane;
        const f32x4 w0 = *(const f32x4*)(a.w_conv + (l * 3 + 0) * 256 + c), w1 = *(const f32x4*)(a.w_conv + (l * 3 + 1) * 256 + c), w2 = *(const f32x4*)(a.w_conv + (l * 3 + 2) * 256 + c);
        f32x4 zp[3];
#pragma unroll
        for (int j = 0; j < 3; ++j) { const int i = t + j;
            if (i < 2) zp[j] = *(const f32x4*)(a.cache_conv + ((size_t)(l * 128 + b) * 2 + i) * 256 + c);
            else { const u32x2 zw = *(const u32x2*)(P + (R + i - 2) * PW + PC_Z + c); zp[j] = (f32x4){bflo(zw.x), bfhi(zw.x), bflo(zw.y), bfhi(zw.y)}; } }
        const u32x2 gw = *(const u32x2*)(P + (R + t) * PW + PC_GB + c); const f32x4 gb = {bflo(gw.x), bfhi(gw.x), bflo(gw.y), bfhi(gw.y)};
        const f32x4 y = gb * (zp[0] * w0 + zp[1] * w1 + zp[2] * w2);
        const float ss = wave_sum(y[0] * y[0] + y[1] * y[1] + y[2] * y[2] + y[3] * y[3]); const float sc = fast_rsqrt(ss * (1.f / 256.f) + EPS);
        u32x2 w; w.x = pk2(y[0] * sc, y[1] * sc); w.y = pk2(y[2] * sc, y[3] * sc); *(u32x2*)(Y + (R + t) * DM + 768 + c) = w;
        if (t >= 2) *(f32x4*)(a.out + O_CS + ((size_t)(l * 128 + b) * 2 + (t - 2)) * 256 + c) = zp[2];
    }
    __syncthreads();
    if (wave < 4) { const int t = wave; float ya[4]; float ss = 0.f;
#pragma unroll
        for (int h = 0; h < 4; ++h) { float mix = a.b_sgu[l * 512 + h * 128 + t];
            for (int s = 0; s <= t; ++s) mix += bf2f(WSG[((size_t)(l * 4 + h) * 128 + t) * 128 + s]) * vS[s * 256 + h * 64 + lane];
            ya[h] = bf2f(P[(R + t) * PW + PC_U + h * 64 + lane]) * mix; ss += ya[h] * ya[h]; }
        ss = wave_sum(ss); const float sc = fast_rsqrt(ss * (1.f / 256.f) + EPS);
#pragma unroll
        for (int h = 0; h < 4; ++h) Y[(R + t) * DM + h * 64 + lane] = f2bf(ya[h] * sc);
    }
    {
        const int h = wave, kvh = h >> 2;
        const float slope = __builtin_amdgcn_exp2f(-(float)(h + 1)); const float sink = a.sinks[l * 8 + h];
        const float* ck = a.cache_k + (size_t)(l * 128 + b) * 128 * 128 + kvh * 64; const float* cv = a.cache_v + (size_t)(l * 128 + b) * 128 * 128 + kvh * 64;
        float sc[3][4];
#pragma unroll
        for (int j = 0; j < 3; ++j)
#pragma unroll
            for (int t = 0; t < 4; ++t) sc[j][t] = 0.f;
#pragma unroll 1
        for (int hh = 0; hh < 4; ++hh) {
            f32x4 kv0[4], kv1[4]; u32x2 kw[4];
#pragma unroll
            for (int d = 0; d < 4; ++d) { kv0[d] = *(const f32x4*)(ck + (size_t)lane * 128 + (hh * 4 + d) * 4); kv1[d] = *(const f32x4*)(ck + (size_t)(lane + 64) * 128 + (hh * 4 + d) * 4);
                kw[d] = (u32x2){0u, 0u}; if (lane < 4) kw[d] = *(const u32x2*)(P + (R + lane) * PW + PC_K + kvh * 64 + (hh * 4 + d) * 4); }
#pragma unroll
            for (int d = 0; d < 4; ++d)
#pragma unroll
                for (int t = 0; t < 4; ++t) { const f32x4 qv = *(const LAS f32x4*)(qS + t * 512 + h * 64 + (hh * 4 + d) * 4);
                    sc[0][t] += kv0[d][0] * qv[0] + kv0[d][1] * qv[1] + kv0[d][2] * qv[2] + kv0[d][3] * qv[3];
                    sc[1][t] += kv1[d][0] * qv[0] + kv1[d][1] * qv[1] + kv1[d][2] * qv[2] + kv1[d][3] * qv[3];
                    sc[2][t] += bflo(kw[d].x) * qv[0] + bfhi(kw[d].x) * qv[1] + bflo(kw[d].y) * qv[2] + bfhi(kw[d].y) * qv[3]; }
        }
#pragma unroll
        for (int t = 0; t < 4; ++t) { float val[3]; float mx = NEGF;
#pragma unroll
            for (int j = 0; j < 3; ++j) { const int kk = lane + 64 * j, dist = 128 + t - kk; const bool valid = (kk < 132) && (dist >= 0) && (dist < 128);
                val[j] = valid ? sc[j][t] * 0.125f - slope * (float)dist : NEGF; mx = fmaxf(mx, val[j]); }
            mx = fmaxf(wave_max(mx), sink); float sum = 0.f;
#pragma unroll
            for (int j = 0; j < 3; ++j) { val[j] = __builtin_amdgcn_exp2f((val[j] - mx) * LOG2E); sum += val[j]; }
            sum = wave_sum(sum); const float inv = 1.0f / (sum + __builtin_amdgcn_exp2f((sink - mx) * LOG2E));
#pragma unroll
            for (int j = 0; j < 3; ++j) { const int kk = lane + 64 * j; if (kk < 132) pS[(wave * 4 + t) * 136 + kk] = val[j] * inv; }
        }
        LDS_WAIT(); __builtin_amdgcn_wave_barrier();
        { const int d4 = (lane & 15) * 4, kq = lane >> 4;
          f32x4 o[4];
#pragma unroll
          for (int t = 0; t < 4; ++t) o[t] = (f32x4){0.f, 0.f, 0.f, 0.f};
#pragma unroll
          for (int bt = 0; bt < 4; ++bt) { f32x4 vv[8];
#pragma unroll
              for (int i = 0; i < 8; ++i) vv[i] = *(const f32x4*)(cv + (size_t)((bt * 8 + i) * 4 + kq) * 128 + d4);
#pragma unroll
              for (int i = 0; i < 8; ++i)
#pragma unroll
                  for (int t = 0; t < 4; ++t) o[t] += vv[i] * pS[(wave * 4 + t) * 136 + (bt * 8 + i) * 4 + kq];
              asm volatile("" ::: "memory"); }
          { const u32x2 vw = *(const u32x2*)(P + (R + kq) * PW + PC_VV + kvh * 64 + d4); const f32x4 vn = {bflo(vw.x), bfhi(vw.x), bflo(vw.y), bfhi(vw.y)};
#pragma unroll
            for (int t = 0; t < 4; ++t) o[t] += vn * pS[(wave * 4 + t) * 136 + 128 + kq]; }
#pragma unroll
          for (int t = 0; t < 4; ++t)
#pragma unroll
              for (int c = 0; c < 4; ++c) { float x = o[t][c]; x += __shfl_xor(x, 16); x += __shfl_xor(x, 32); o[t][c] = x; }
          if (kq == 0) {
#pragma unroll
              for (int t = 0; t < 4; ++t) *(LAS f32x4*)(ybS + t * 512 + h * 64 + d4) = o[t]; }
        }
    }
    __syncthreads();
    if (wave < 4) { const int t = wave; float v[8]; float ss = 0.f;
#pragma unroll
        for (int j = 0; j < 8; ++j) { v[j] = ybS[t * 512 + lane * 8 + j]; ss += v[j] * v[j]; }
        ss = wave_sum(ss); const float sc = fast_rsqrt(ss * (1.f / 512.f) + EPS);
        u32x4 w; w.x = pk2(v[0] * sc, v[1] * sc); w.y = pk2(v[2] * sc, v[3] * sc); w.z = pk2(v[4] * sc, v[5] * sc); w.w = pk2(v[6] * sc, v[7] * sc);
        *(u32x4*)(Y + (R + t) * DM + 256 + lane * 8) = w;
    }
    for (int i = tid; i < 4096; i += 512) { const int w = i >> 5, c4 = (i & 31) * 4; f32x4 kv, vv;
        if (w < 124) { kv = *(const f32x4*)(a.cache_k + ((size_t)(l * 128 + b) * 128 + w + 4) * 128 + c4); vv = *(const f32x4*)(a.cache_v + ((size_t)(l * 128 + b) * 128 + w + 4) * 128 + c4); }
        else { const u32x2 kw = *(const u32x2*)(P + (R + w - 124) * PW + PC_K + c4), vw = *(const u32x2*)(P + (R + w - 124) * PW + PC_VV + c4);
            kv = (f32x4){bflo(kw.x), bfhi(kw.x), bflo(kw.y), bfhi(kw.y)}; vv = (f32x4){bflo(vw.x), bfhi(vw.x), bflo(vw.y), bfhi(vw.y)}; }
        *(f32x4*)(a.out + O_KS + ((size_t)(l * 128 + b) * 128 + w) * 128 + c4) = kv; *(f32x4*)(a.out + O_VS + ((size_t)(l * 128 + b) * 128 + w) * 128 + c4) = vv; }
    __syncthreads();
}

__global__ void __launch_bounds__(512) mega_fwd(Args a_in) {
#if defined(__HIP_DEVICE_COMPILE__)
    extern __shared__ __attribute__((aligned(16))) unsigned char lds_raw[];
    LAS unsigned char* lds = (LAS unsigned char*)lds_raw;
    cg::grid_group grid = cg::this_grid();
    typedef const __attribute__((address_space(4))) Args* KArgsPtr;
    KArgsPtr ap0 = (KArgsPtr)__builtin_amdgcn_kernarg_segment_ptr();
#define ARGS() ({ KArgsPtr p_ = ap0; asm volatile("" : "+s"(p_)); *p_; })
    const int G = gridDim.x;
    volatile LAS unsigned* bst = (volatile LAS unsigned*)(lds + LDS_BYTES - 16);
    if (threadIdx.x == 0) { bst[0] = 0u; bst[1] = 0u; const Args a = ARGS(); (void)xb_add((unsigned*)(a.ws + WS_BAR) + XB_XCNT(xb_xcc_id()), 1u); }
    __syncthreads();
#define GBAR() do { const Args a_ = ARGS(); xcd_barrier((unsigned*)(a_.ws + WS_BAR), bst); } while (0)
    for (int rep = 0; rep < REP_PRO; ++rep) { const Args a = ARGS(); phase_prologue(a, lds); }
    { const Args a = ARGS(); if (a.ws == nullptr) grid.sync(); }
    GBAR();
    for (int l = 0; l < DEPTH; ++l) {
        for (int step = 0; step < 3; ++step) {
            if (step != 1) {
                const int f = step >> 1, mat = l * 2 + f;
                for (int rep = 0; rep < REP_GEMM; ++rep) { const Args a = ARGS(); unsigned char* ws = a.ws;
                  pg8::Gemm g{(const bf16_t*)(ws + WS_XB), (const bf16_t*)(ws + WS_WGU) + (size_t)mat * NGU * DM, T, NGU, DM}; pg8::StaticOrder S; S.init(T, NGU, G, (int)blockIdx.x);
                  pg8::EpiSwiglu E{(bf16_t*)(ws + WS_ACT), (const float*)(ws + WS_RS)}; pg8::gemm_phase<pg8::EpiSwiglu, true, true>(lds, g, S, E); }
                GBAR();
                { const Args a = ARGS(); unsigned char* ws = a.ws; const int inst = l * 3 + step;
                  pg8::Gemm g{(const bf16_t*)(ws + WS_ACT), (const bf16_t*)(ws + WS_WDN) + (size_t)mat * DM * FF, TP, DM, FF}; pg8::StaticOrder S; S.init(TP, DM, G, (int)blockIdx.x);
                  SEpiF32 SE{(float*)(ws + WS_DM), DM};
                  for (int it = blockIdx.x; it < 256; it += G) { const int n0[2] = {(it & 15) * 64, (it & 15) * 64 + 32}; small_gemm_item<2, 11, SEpiF32>(lds, g.A, g.Bt, FF, TP + (it >> 4) * 32, n0, SE); small_items_done((unsigned*)(ws + WS_BAR)); }
                  const float* gn = a.norm_g + (l * 6 + (f ? 5 : 1)) * DM;
                  const bool last = (inst == 11);
                  pg8::EpiResNorm E{last ? a.out : (float*)nullptr, (bf16_t*)(ws + WS_XB), (float*)(ws + WS_PS1), (float*)(ws + WS_RS), (unsigned*)(ws + WS_BAR), gn, 0.5f, 4u * (unsigned)(inst + 1)};
                  pg8::gemm_phase<pg8::EpiResNorm, false, true>(lds, g, S, E);
                  sample_resnorm(a, gn, 0.5f, 256u * (unsigned)(inst + 1), last); }
                GBAR();
            } else {
                for (int rep = 0; rep < REP_GEMM; ++rep) { const Args a = ARGS(); unsigned char* ws = a.ws;
                  pg8::Gemm g{(const bf16_t*)(ws + WS_XB), (const bf16_t*)(ws + WS_WIN) + (size_t)l * NIN * DM, TP, NIN, DM}; pg8::StaticOrder S; S.init(TP, NIN, G, (int)blockIdx.x);
                  pg8::EpiMixIn E{(bf16_t*)(ws + WS_P), (const float*)(ws + WS_RS)}; pg8::gemm_phase<pg8::EpiMixIn, true, true>(lds, g, S, E);
                  SEpiMixIn SE{(bf16_t*)(ws + WS_P), (const float*)(ws + WS_RS)};
                  for (int it = blockIdx.x; it < 256; it += G) { const int cg_ = it & 15; int n0[4];
                      if (cg_ < 12) { n0[0] = cg_ * 128; n0[1] = n0[0] + 32; n0[2] = n0[0] + 64; n0[3] = n0[0] + 96; }
                      else { const int q = cg_ - 12; n0[0] = 1536 + 256 * (q >> 1) + 64 * (q & 1); n0[1] = n0[0] + 32; n0[2] = n0[0] + 128; n0[3] = n0[0] + 160; }
                      small_gemm_item<4, 8, SEpiMixIn>(lds, g.A, g.Bt, DM, TP + (it >> 4) * 32, n0, SE); } }
                GBAR();
                for (int rep = 0; rep < REP_MIX; ++rep) {
                    for (int it = blockIdx.x; it < 256; it += G) {
                        if (it < 128) { for (int r2 = 0; r2 < REP_ATT; ++r2) { const Args a = ARGS(); mixer_att_item(a, l, it >> 4, it & 15, lds); } }
                        else { for (int r2 = 0; r2 < REP_SGU; ++r2) { const Args a = ARGS(); mixer_sgu_item(a, l, (it - 128) >> 4, (it - 128) & 15, lds); } }
                    }
                    for (int it = ((int)blockIdx.x >= 128 ? (int)blockIdx.x - 128 : (int)blockIdx.x + G - 128); it < 128; it += G) for (int r2 = 0; r2 < REP_SMP; ++r2) { const Args a = ARGS(); mixer_sample_item(a, l, it, lds); }
                }
                GBAR();
                { const Args a = ARGS(); unsigned char* ws = a.ws; const int inst = l * 3 + step;
                  pg8::Gemm g{(const bf16_t*)(ws + WS_Y), (const bf16_t*)(ws + WS_WOUT) + (size_t)l * DM * DM, TP, DM, DM}; pg8::StaticOrder S; S.init(TP, DM, G, (int)blockIdx.x);
                  SEpiF32 SE{(float*)(ws + WS_DM), DM};
                  for (int it = blockIdx.x; it < 256; it += G) { const int n0[2] = {(it & 15) * 64, (it & 15) * 64 + 32}; small_gemm_item<2, 8, SEpiF32>(lds, g.A, g.Bt, DM, TP + (it >> 4) * 32, n0, SE); small_items_done((unsigned*)(ws + WS_BAR)); }
                  const float* gn = a.norm_g + (l * 6 + 3) * DM;
                  pg8::EpiResNorm E{(float*)nullptr, (bf16_t*)(ws + WS_XB), (float*)(ws + WS_PS1), (float*)(ws + WS_RS), (unsigned*)(ws + WS_BAR), gn, 1.0f, 4u * (unsigned)(inst + 1)};
                  pg8::gemm_phase<pg8::EpiResNorm, false, true>(lds, g, S, E);
                  sample_resnorm(a, gn, 1.0f, 256u * (unsigned)(inst + 1), false); }
                GBAR();
            }
        }
    }
#undef GBAR
#undef ARGS
#endif
}

extern "C" void kernel_launch(void* const* d_in, const int* in_sizes, int n_in, void* d_out, int out_size, void* d_ws, size_t ws_size, hipStream_t stream) {
    static int grid_blocks = 0;
    if (!grid_blocks) {
        int dev = 0, cus = 0, per_cu = 0;
        hipGetDevice(&dev);
        hipDeviceGetAttribute(&cus, hipDeviceAttributeMultiprocessorCount, dev);
        hipFuncSetAttribute((const void*)mega_fwd, hipFuncAttributeMaxDynamicSharedMemorySize, LDS_BYTES);
        hipOccupancyMaxActiveBlocksPerMultiprocessor(&per_cu, (const void*)mega_fwd, 512, LDS_BYTES);
        if (per_cu < 1) per_cu = 1;
        grid_blocks = cus * per_cu;
        if (ws_size < WS_END) fprintf(stderr, "kernel_launch: workspace too small (%zu < %zu)\n", ws_size, (size_t)WS_END);
    }
    Args a{};
    a.x_prompt = (const float*)d_in[0]; a.x_sample = (const float*)d_in[1]; a.cache_k = (const float*)d_in[2]; a.cache_v = (const float*)d_in[3]; a.cache_conv = (const float*)d_in[4];
    a.norm_g = (const float*)d_in[5]; a.w_gu = (const float*)d_in[6]; a.w_down = (const float*)d_in[7]; a.w_in = (const float*)d_in[8]; a.w_out = (const float*)d_in[9];
    a.g_out = (const float*)d_in[10]; a.w_sgu = (const float*)d_in[11]; a.b_sgu = (const float*)d_in[12]; a.g_sgu = (const float*)d_in[13]; a.sinks = (const float*)d_in[14]; a.w_conv = (const float*)d_in[15];
    a.out = (float*)d_out; a.ws = (unsigned char*)d_ws;
    hipMemsetAsync((char*)d_ws + WS_BAR, 0, CTL_BYTES, stream);
    void* args[] = {&a};
    hipError_t e = hipLaunchCooperativeKernel((const void*)mega_fwd, dim3(grid_blocks), dim3(512), args, LDS_BYTES, stream);
    if (e != hipSuccess) fprintf(stderr, "cooperative launch failed: %s (grid %d)\n", hipGetErrorString(e), grid_blocks);
}
```
